# Optimizing an MI355X kernel written in HIP

```python
import jax, jax.numpy as jnp
from jax import lax
import numpy as np

D_MODEL = 2048
BATCH = 2
SEQ = 8192
DEPTH = 1

MEM_LEN = 256
POOL_WINDOWS = (2, 4, 8, 16)
POOL_GROUP_DIM = D_MODEL // 16
POOL_WIDTH = len(POOL_WINDOWS) * POOL_GROUP_DIM
LRU_WIDTH = D_MODEL // 2
LRU_BLOCKS = 8
LRU_BLOCK_DIM = LRU_WIDTH // LRU_BLOCKS
CONV_WIDTH = 4
LRU_C = 8.0
MEM_HEADS = 4
MEM_HEAD_DIM = D_MODEL // 16
MEM_WIDTH = MEM_HEADS * MEM_HEAD_DIM
MIX_WIDTH = POOL_WIDTH + LRU_WIDTH + MEM_WIDTH
IN_WIDTH = POOL_WIDTH + 2 * LRU_WIDTH + MEM_WIDTH
N_GROUPS = 4
EXPERTS_PER_GROUP = 8
N_EXPERTS = N_GROUPS * EXPERTS_PER_GROUP
TOP_K = 2
EXPERT_FF = D_MODEL // 2
EXPERT_BLOCK = 128
ALPHA = (2 * DEPTH) ** 0.25
BETA = (8 * DEPTH) ** -0.25
EPS = 1e-5

kernel_name = 'hybrid_pool_rglru_memattn_hmoe_deepnorm'


def layer_norm(x, g, b):
    xf = x.astype(jnp.float32)
    mu = jnp.mean(xf, -1, keepdims=True)
    var = jnp.mean(jnp.square(xf - mu), -1, keepdims=True)
    return ((xf - mu) * lax.rsqrt(var + EPS) * g + b).astype(x.dtype)


def rms_norm(x, g):
    xf = x.astype(jnp.float32)
    return (xf * lax.rsqrt(jnp.mean(jnp.square(xf), -1, keepdims=True) + EPS) * g).astype(x.dtype)


def pool_mixer(u, w_pool, pool_scale):
    B, S, _ = u.shape
    uf = u.astype(jnp.float32)
    cs = jnp.cumsum(uf, axis=1)
    pos = jnp.arange(1, S + 1, dtype=jnp.float32)[None, :, None]
    parts = []
    for g, w in enumerate(POOL_WINDOWS):
        sl = slice(g * POOL_GROUP_DIM, (g + 1) * POOL_GROUP_DIM)
        c = cs[..., sl]
        prev = jnp.pad(c[:, :-w], ((0, 0), (w, 0), (0, 0)))
        parts.append((c - prev) / jnp.minimum(pos, float(w)) - uf[..., sl])
    d = jnp.stack(parts, axis=2).astype(u.dtype)
    y = jnp.einsum('bsgc,gcd->bsgd', d, w_pool).reshape(B, S, POOL_WIDTH)
    return y * pool_scale


def _linear_scan_combine(left, right):
    a_l, b_l = left
    a_r, b_r = right
    return a_l * a_r, a_r * b_l + b_r


def rglru_mixer(u, gate, conv_w, conv_b, w_a, b_a, w_x, b_x, lam):
    B, S, C = u.shape
    uc = lax.conv_general_dilated(u, conv_w[:, None, :], window_strides=(1,), padding=[(CONV_WIDTH - 1, 0)],
                                  dimension_numbers=('NWC', 'WIO', 'NWC'), feature_group_count=C) + conv_b
    ub = uc.reshape(B, S, LRU_BLOCKS, LRU_BLOCK_DIM)
    r = jax.nn.sigmoid(jnp.einsum('bshc,hcd->bshd', ub, w_a).reshape(B, S, C) + b_a).astype(jnp.float32)
    i = jax.nn.sigmoid(jnp.einsum('bshc,hcd->bshd', ub, w_x).reshape(B, S, C) + b_x).astype(jnp.float32)
    log_a = -LRU_C * r * jax.nn.softplus(-lam.astype(jnp.float32))
    a = jnp.exp(log_a)
    mult = jnp.sqrt(jnp.maximum(-jnp.expm1(2.0 * log_a), 0.0))
    bterm = mult * i * uc.astype(jnp.float32)
    _, h = lax.associative_scan(_linear_scan_combine, (a, bterm), axis=1)
    return jax.nn.gelu(gate) * h.astype(gate.dtype)


def memory_attention(q, mem, w_mem_kv):
    B, S, _ = q.shape
    M = mem.shape[1]
    kv = jnp.einsum('bmd,de->bme', mem, w_mem_kv)
    k = kv[..., :MEM_WIDTH].reshape(B, M, MEM_HEADS, MEM_HEAD_DIM)
    v = kv[..., MEM_WIDTH:].reshape(B, M, MEM_HEADS, MEM_HEAD_DIM)
    qh = q.reshape(B, S, MEM_HEADS, MEM_HEAD_DIM)
    s = jnp.einsum('bshd,bmhd->bhsm', qh, k).astype(jnp.float32) * (MEM_HEAD_DIM ** -0.5)
    p = jax.nn.softmax(s, axis=-1).astype(v.dtype)
    return jnp.einsum('bhsm,bmhd->bshd', p, v).reshape(B, S, MEM_WIDTH)


def mixer_sublayer(x, mem, w_in, w_pool, pool_scale, conv_w, conv_b, w_a, b_a, w_x, b_x, lam,
                   w_mem_kv, mix_norm_g, w_out):
    h = jnp.einsum('bsd,de->bse', x, w_in)
    o1 = POOL_WIDTH
    o2 = o1 + LRU_WIDTH
    o3 = o2 + LRU_WIDTH
    y_pool = pool_mixer(h[..., :o1], w_pool, pool_scale)
    y_lru = rglru_mixer(h[..., o1:o2], h[..., o2:o3], conv_w, conv_b, w_a, b_a, w_x, b_x, lam)
    y_mem = memory_attention(h[..., o3:], mem, w_mem_kv)
    m1 = POOL_WIDTH
    m2 = m1 + LRU_WIDTH
    mix = jnp.concatenate([rms_norm(y_pool, mix_norm_g[:m1]),
                           rms_norm(y_lru, mix_norm_g[m1:m2]),
                           rms_norm(y_mem, mix_norm_g[m2:])], axis=-1)
    return jnp.einsum('bse,ed->bsd', mix, w_out)


def hier_moe(x, w_group, b_group, w_fine, b_fine, w_gate, w_up, w_down):
    B, S, D = x.shape
    N = B * S
    xt = x.reshape(N, D)
    g_prob = jax.nn.softmax(jnp.dot(xt, w_group).astype(jnp.float32) + b_group, axis=-1)
    g_p, g_idx = lax.top_k(g_prob, 1)
    f_logits = jnp.dot(xt, w_fine).astype(jnp.float32).reshape(N, N_GROUPS, EXPERTS_PER_GROUP) + b_fine
    f_sel = jnp.take_along_axis(f_logits, g_idx[:, :, None], axis=1)[:, 0]
    top_l, top_j = lax.top_k(f_sel, TOP_K)
    top_w = jax.nn.softmax(top_l, axis=-1) * g_p
    e_idx = g_idx * EXPERTS_PER_GROUP + top_j
    A = N * TOP_K
    e_flat = e_idx.reshape(A)
    w_flat = top_w.reshape(A)
    tok_flat = jnp.repeat(jnp.arange(N, dtype=jnp.int32), TOP_K)
    order = jnp.argsort(e_flat, stable=True)
    e_sorted = e_flat[order]
    counts = jnp.bincount(e_flat, length=N_EXPERTS)
    starts = jnp.cumsum(counts) - counts
    padded = (counts + EXPERT_BLOCK - 1) // EXPERT_BLOCK * EXPERT_BLOCK
    pad_ends = jnp.cumsum(padded)
    pad_starts = pad_ends - padded
    dest = pad_starts[e_sorted] + jnp.arange(A, dtype=jnp.int32) - starts[e_sorted]
    n_blocks = (A + N_EXPERTS * EXPERT_BLOCK + EXPERT_BLOCK - 1) // EXPERT_BLOCK
    P = n_blocks * EXPERT_BLOCK
    buf_tok = jnp.full((P,), N, jnp.int32).at[dest].set(tok_flat[order])
    buf_w = jnp.zeros((P,), jnp.float32).at[dest].set(w_flat[order])
    block_start = jnp.arange(n_blocks, dtype=jnp.int32) * EXPERT_BLOCK
    block_exp = jnp.minimum(jnp.searchsorted(pad_ends, block_start, side='right'), N_EXPERTS - 1)
    x_pad = jnp.concatenate([xt, jnp.zeros((1, D), xt.dtype)], axis=0)
    xb = x_pad[buf_tok].reshape(n_blocks, EXPERT_BLOCK, D)

    def expert_block(args):
        xblk, e = args
        hdn = jax.nn.silu(xblk @ w_gate[e]) * (xblk @ w_up[e])
        return hdn @ w_down[e]

    yb = lax.map(expert_block, (xb, block_exp)).reshape(P, D)
    yb = yb * buf_w[:, None].astype(yb.dtype)
    out = jnp.zeros((N + 1, D), yb.dtype).at[buf_tok].add(yb)[:N]
    return out.reshape(B, S, D)


def setup_inputs(seed: int = 0) -> dict:
    key = jax.random.key(seed)
    ks = jax.random.split(key, 28)
    nrm = lambda k, shape, scale: jax.random.normal(k, shape, jnp.float32) * scale
    L, D = DEPTH, D_MODEL
    u = jax.random.uniform(ks[10], (L, LRU_WIDTH), jnp.float32, minval=0.9, maxval=0.999)
    s = u ** (1.0 / LRU_C)
    lam = jnp.log(s) - jnp.log1p(-s)
    w_mem_kv = jnp.concatenate([nrm(ks[11], (L, D, MEM_WIDTH), D ** -0.5),
                                nrm(ks[12], (L, D, MEM_WIDTH), BETA * D ** -0.5)], axis=-1)
    return {
        'x': nrm(ks[0], (BATCH, SEQ, D), 1.0),
        'mem': nrm(ks[1], (BATCH, MEM_LEN, D), 1.0),
        'w_in': nrm(ks[2], (L, D, IN_WIDTH), D ** -0.5),
        'w_pool': nrm(ks[3], (L, len(POOL_WINDOWS), POOL_GROUP_DIM, POOL_GROUP_DIM), POOL_GROUP_DIM ** -0.5),
        'pool_scale': 1.0 + nrm(ks[4], (L, POOL_WIDTH), 0.1),
        'conv_w': nrm(ks[5], (L, CONV_WIDTH, LRU_WIDTH), CONV_WIDTH ** -0.5),
        'conv_b': nrm(ks[6], (L, LRU_WIDTH), 0.02),
        'w_a': nrm(ks[7], (L, LRU_BLOCKS, LRU_BLOCK_DIM, LRU_BLOCK_DIM), LRU_BLOCK_DIM ** -0.5),
        'b_a': nrm(ks[8], (L, LRU_WIDTH), 0.02),
        'w_x': nrm(ks[9], (L, LRU_BLOCKS, LRU_BLOCK_DIM, LRU_BLOCK_DIM), LRU_BLOCK_DIM ** -0.5),
        'b_x': nrm(ks[13], (L, LRU_WIDTH), 0.02),
        'lam': lam,
        'w_mem_kv': w_mem_kv,
        'mix_norm_g': 1.0 + nrm(ks[14], (L, MIX_WIDTH), 0.02),
        'w_out': nrm(ks[15], (L, MIX_WIDTH, D), BETA * MIX_WIDTH ** -0.5),
        'ln1_g': 1.0 + nrm(ks[16], (L, D), 0.02),
        'ln1_b': nrm(ks[17], (L, D), 0.02),
        'w_group': nrm(ks[18], (L, D, N_GROUPS), D ** -0.5),
        'b_group': nrm(ks[19], (L, N_GROUPS), 0.01),
        'w_fine': nrm(ks[20], (L, D, N_EXPERTS), D ** -0.5),
        'b_fine': nrm(ks[21], (L, N_GROUPS, EXPERTS_PER_GROUP), 0.01),
        'w_gate': nrm(ks[22], (L, N_EXPERTS, D, EXPERT_FF), D ** -0.5),
        'w_up': nrm(ks[23], (L, N_EXPERTS, D, EXPERT_FF), D ** -0.5),
        'w_down': nrm(ks[24], (L, N_EXPERTS, EXPERT_FF, D), BETA * EXPERT_FF ** -0.5),
        'ln2_g': 1.0 + nrm(ks[25], (L, D), 0.02),
        'ln2_b': nrm(ks[26], (L, D), 0.02),
    }


def reference(x, mem, w_in, w_pool, pool_scale, conv_w, conv_b, w_a, b_a, w_x, b_x, lam, w_mem_kv,
              mix_norm_g, w_out, ln1_g, ln1_b, w_group, b_group, w_fine, b_fine, w_gate, w_up, w_down,
              ln2_g, ln2_b):
    for l in range(DEPTH):
        y = mixer_sublayer(x, mem, w_in[l], w_pool[l], pool_scale[l], conv_w[l], conv_b[l], w_a[l], b_a[l],
                           w_x[l], b_x[l], lam[l], w_mem_kv[l], mix_norm_g[l], w_out[l])
        x = layer_norm(ALPHA * x + y, ln1_g[l], ln1_b[l])
        y = hier_moe(x, w_group[l], b_group[l], w_fine[l], b_fine[l], w_gate[l], w_up[l], w_down[l])
        x = layer_norm(ALPHA * x + y, ln2_g[l], ln2_b[l])
    return x
```

```cpp
#include <hip/hip_runtime.h>
#include <hip/hip_cooperative_groups.h>
#include <cstdio>
#include <cstdint>
namespace cg = cooperative_groups;

#define DEVI __device__ __forceinline__
#ifndef ONE_LAUNCH
#define ONE_LAUNCH 1
#endif

constexpr int D = 2048, BATCH = 2, SEQ = 8192, M = BATCH * SEQ, MEMLEN = 256;
constexpr int POOLW = 512, LRUW = 1024, MEMW = 512, MIXW = 2048, INW = 3072;
constexpr int NG = 4, EPG = 8, NE = 32, FF = 1024;
constexpr float ALPHA = 1.189207115002721f;
constexpr float EPS = 1e-5f;
constexpr int NT = 512;

constexpr size_t MiB = 1u << 20;
constexpr size_t WS_CTL = 0;
constexpr size_t WS_KB = 1 * MiB, WS_VT = 1 * MiB + 512 * 1024;
constexpr size_t WS_ASG_E = 2 * MiB, WS_ASG_S = WS_ASG_E + 128 * 1024, WS_ASG_W = WS_ASG_S + 128 * 1024, WS_ASG_R = WS_ASG_W + 128 * 1024;
constexpr size_t WS_X1B = 424 * MiB;
constexpr size_t WS_HB = 488 * MiB;
constexpr size_t WS_MIX = 584 * MiB;
constexpr size_t WS_XG = 488 * MiB;
constexpr size_t WS_HD = 652 * MiB;
constexpr size_t WS_YB = 488 * MiB;
constexpr size_t WS_TMP = 652 * MiB;
constexpr size_t WS_YPOOL = WS_TMP, WS_AS = WS_TMP + 32 * MiB, WS_BS = WS_AS + 64 * MiB, WS_YLRU = WS_BS + 64 * MiB, WS_YMEM = WS_YLRU + 64 * MiB;
constexpr size_t WS_END = WS_YMEM + 32 * MiB;
constexpr int ROWS_MAX = 2 * M + NE * 256;
constexpr int CW_CNT = 64;

typedef unsigned short bf16_t;
DEVI float bf2f(bf16_t v) { return __uint_as_float(((unsigned)v) << 16); }
DEVI bf16_t f2bf(float f) { unsigned u = __float_as_uint(f); return (bf16_t)((u + 0x7fffu + ((u >> 16) & 1u)) >> 16); }

struct P { const float* in[26]; float* out; unsigned char* ws; };
enum { I_X = 0, I_MEM, I_WIN, I_WPOOL, I_PSCALE, I_CONVW, I_CONVB, I_WA, I_BA, I_WX, I_BX, I_LAM, I_WKV, I_MIXG, I_WOUT, I_LN1G, I_LN1B,
       I_WGROUP, I_BGROUP, I_WFINE, I_BFINE, I_WGATE, I_WUP, I_WDOWN, I_LN2G, I_LN2B };

DEVI float wave_sum(float v) {
#pragma unroll
    for (int o = 1; o < 64; o <<= 1) v += __shfl_xor(v, o);
    return v;
}
DEVI float wave_max(float v) {
#pragma unroll
    for (int o = 1; o < 64; o <<= 1) v = fmaxf(v, __shfl_xor(v, o));
    return v;
}
DEVI int permkey(int key) { const int k = key & 31; return (key & ~31) | (k & 16) | (((k >> 2) & 1) << 3) | (((k >> 3) & 1) << 2) | (k & 3); }

template <bool DUAL, class AL, class BL, class BL2, class EP>
DEVI void sgemm_tile(int m0, int n0, int K, AL aload, BL bload, BL2 bload2, EP epi, float* sm) {
    float* As = sm;
    float* Bs = sm + 16 * 132;
    float* Bs2 = Bs + 16 * 68;
    const int tid = threadIdx.x, ty = tid >> 4, tx = tid & 15;
    float acc[4][4], acc2[4][4];
#pragma unroll
    for (int i = 0; i < 4; ++i)
#pragma unroll
        for (int j = 0; j < 4; ++j) { acc[i][j] = 0.f; acc2[i][j] = 0.f; }
    for (int k0 = 0; k0 < K; k0 += 16) {
#pragma unroll
        for (int i = 0; i < 4; ++i) { const int e = tid + i * NT, r = e >> 4, kk = e & 15; As[kk * 132 + r] = aload(m0 + r, k0 + kk); }
#pragma unroll
        for (int i = 0; i < 2; ++i) { const int e = tid + i * NT, kk = e >> 6, n = e & 63; Bs[kk * 68 + n] = bload(k0 + kk, n0 + n); if (DUAL) Bs2[kk * 68 + n] = bload2(k0 + kk, n0 + n); }
        __syncthreads();
#pragma unroll
        for (int kk = 0; kk < 16; ++kk) {
            const float4 a = *(const float4*)(As + kk * 132 + ty * 4);
            const float4 b = *(const float4*)(Bs + kk * 68 + tx * 4);
            const float av[4] = {a.x, a.y, a.z, a.w}, bv[4] = {b.x, b.y, b.z, b.w};
#pragma unroll
            for (int i = 0; i < 4; ++i)
#pragma unroll
                for (int j = 0; j < 4; ++j) acc[i][j] = fmaf(av[i], bv[j], acc[i][j]);
            if (DUAL) {
                const float4 b2 = *(const float4*)(Bs2 + kk * 68 + tx * 4);
                const float bw[4] = {b2.x, b2.y, b2.z, b2.w};
#pragma unroll
                for (int i = 0; i < 4; ++i)
#pragma unroll
                    for (int j = 0; j < 4; ++j) acc2[i][j] = fmaf(av[i], bw[j], acc2[i][j]);
            }
        }
        __syncthreads();
    }
#pragma unroll
    for (int i = 0; i < 4; ++i)
#pragma unroll
        for (int j = 0; j < 4; ++j) epi(m0 + ty * 4 + i, n0 + tx * 4 + j, acc[i][j], acc2[i][j]);
}

DEVI void s1_inproj(const P& p, float* sm) {
    const float* x = p.in[I_X]; const float* w = p.in[I_WIN]; bf16_t* hb = (bf16_t*)(p.ws + WS_HB);
    const int ntn = INW / 64, nt = (M / 128) * ntn;
    for (int it = blockIdx.x; it < nt; it += gridDim.x) {
        const int m0 = (it / ntn) * 128, n0 = (it % ntn) * 64;
        auto al = [&](int r, int k) { return x[(size_t)r * D + k]; };
        auto bl = [&](int k, int n) { return w[(size_t)k * INW + n]; };
        auto ep = [&](int r, int n, float v, float) { hb[(size_t)r * INW + n] = f2bf(v); };
        sgemm_tile<false>(m0, n0, D, al, bl, bl, ep, sm);
    }
    const float* mem = p.in[I_MEM]; const float* wkv = p.in[I_WKV]; bf16_t* kb = (bf16_t*)(p.ws + WS_KB); bf16_t* vt = (bf16_t*)(p.ws + WS_VT);
    const int nt2 = (BATCH * MEMLEN / 128) * (2 * MEMW / 64);
    for (int it = blockIdx.x; it < nt2; it += gridDim.x) {
        const int m0 = (it / 16) * 128, n0 = (it % 16) * 64;
        auto al = [&](int r, int k) { return mem[(size_t)r * D + k]; };
        auto bl = [&](int k, int n) { return wkv[(size_t)k * (2 * MEMW) + n]; };
        auto ep = [&](int r, int n, float v, float) {
            const int b = r / MEMLEN, key = r % MEMLEN;
            if (n < MEMW) { const int hd = n >> 7, d = n & 127; kb[((size_t)(b * 4 + hd) * MEMLEN + key) * 128 + d] = f2bf(v); }
            else { const int n2 = n - MEMW, hd = n2 >> 7, d = n2 & 127; vt[((size_t)(b * 4 + hd) * 128 + d) * MEMLEN + permkey(key)] = f2bf(v); }
        };
        sgemm_tile<false>(m0, n0, D, al, bl, bl, ep, sm);
    }
}
DEVI void s2a_pool(const P& p, float* sm) {
    const bf16_t* hb = (const bf16_t*)(p.ws + WS_HB); float* ypool = (float*)(p.ws + WS_YPOOL);
    const float* wp = p.in[I_WPOOL]; const float* ps = p.in[I_PSCALE];
    const int tid = threadIdx.x, g = tid >> 7, c = tid & 127, w = 2 << g;
    for (int t = blockIdx.x; t < M; t += gridDim.x) {
        const int pos = t % SEQ;
        float s = 0.f;
        for (int j = 0; j < w; ++j) if (pos - j >= 0) s += bf2f(hb[(size_t)(t - j) * INW + g * 128 + c]);
        const float cntf = (float)((pos + 1 < w) ? pos + 1 : w);
        sm[tid] = s / cntf - bf2f(hb[(size_t)t * INW + g * 128 + c]);
        __syncthreads();
        float y = 0.f;
        for (int cc = 0; cc < 128; ++cc) y = fmaf(sm[g * 128 + cc], wp[((size_t)g * 128 + cc) * 128 + c], y);
        ypool[(size_t)t * POOLW + g * 128 + c] = y * ps[g * 128 + c];
        __syncthreads();
    }
}
DEVI float sigmoidf_(float v) { return 1.f / (1.f + __expf(-v)); }
DEVI void s2b_lru(const P& p, float* sm) {
    const bf16_t* hb = (const bf16_t*)(p.ws + WS_HB); float* aS = (float*)(p.ws + WS_AS); float* bS = (float*)(p.ws + WS_BS);
    const float* cw = p.in[I_CONVW]; const float* cb = p.in[I_CONVB]; const float* wa = p.in[I_WA]; const float* ba = p.in[I_BA];
    const float* wx = p.in[I_WX]; const float* bx = p.in[I_BX]; const float* lam = p.in[I_LAM];
    const int tid = threadIdx.x;
    for (int it = blockIdx.x; it < M / 8; it += gridDim.x) {
        const int t0 = it * 8;
#pragma unroll
        for (int q = 0; q < 2; ++q) { const int c = tid + q * NT;
            for (int tt = 0; tt < 8; ++tt) { const int t = t0 + tt, pos = t % SEQ; float u = cb[c];
#pragma unroll
                for (int j = 0; j < 4; ++j) if (pos - 3 + j >= 0) u = fmaf(cw[j * LRUW + c], bf2f(hb[(size_t)(t - 3 + j) * INW + POOLW + c]), u);
                sm[tt * LRUW + c] = u; } }
        __syncthreads();
#pragma unroll
        for (int q = 0; q < 2; ++q) { const int n = tid + q * NT, h = n >> 7, nn = n & 127;
            float ra[8], rx[8];
#pragma unroll
            for (int tt = 0; tt < 8; ++tt) { ra[tt] = ba[n]; rx[tt] = bx[n]; }
            for (int c = 0; c < 128; ++c) { const float w1 = wa[((size_t)h * 128 + c) * 128 + nn], w2 = wx[((size_t)h * 128 + c) * 128 + nn];
#pragma unroll
                for (int tt = 0; tt < 8; ++tt) { const float u = sm[tt * LRUW + h * 128 + c]; ra[tt] = fmaf(u, w1, ra[tt]); rx[tt] = fmaf(u, w2, rx[tt]); } }
            const float sp = log1pf(expf(-lam[n]));
#pragma unroll
            for (int tt = 0; tt < 8; ++tt) { const float r = sigmoidf_(ra[tt]), ii = sigmoidf_(rx[tt]);
                const float la = -8.f * r * sp, a = expf(la), mult = sqrtf(fmaxf(-expm1f(2.f * la), 0.f));
                aS[(size_t)(t0 + tt) * LRUW + n] = a; bS[(size_t)(t0 + tt) * LRUW + n] = mult * ii * sm[tt * LRUW + n]; } }
        __syncthreads();
    }
}
DEVI float gelu_tanh(float v) { const float u = 0.7978845608028654f * (v + 0.044715f * v * v * v); return 0.5f * v * (1.f + tanhf(u)); }
DEVI void s2c_scan(const P& p, float*) {
    const bf16_t* hb = (const bf16_t*)(p.ws + WS_HB); const float* aS = (const float*)(p.ws + WS_AS); const float* bS = (const float*)(p.ws + WS_BS); float* ylru = (float*)(p.ws + WS_YLRU);
    const int idx = blockIdx.x * NT + threadIdx.x;
    if (idx >= BATCH * LRUW) return;
    const int b = idx / LRUW, c = idx % LRUW; float h = 0.f;
    for (int s0 = 0; s0 < SEQ; s0 += 8) {
        float a[8], bb[8], g[8];
#pragma unroll
        for (int j = 0; j < 8; ++j) { const size_t t = (size_t)b * SEQ + s0 + j; a[j] = aS[t * LRUW + c]; bb[j] = bS[t * LRUW + c]; g[j] = bf2f(hb[t * INW + POOLW + LRUW + c]); }
#pragma unroll
        for (int j = 0; j < 8; ++j) { h = fmaf(a[j], h, bb[j]); ylru[((size_t)b * SEQ + s0 + j) * LRUW + c] = gelu_tanh(g[j]) * h; }
    }
}
DEVI void s2d_attn(const P& p, float* sm) {
    const bf16_t* hb = (const bf16_t*)(p.ws + WS_HB); const bf16_t* kb = (const bf16_t*)(p.ws + WS_KB); const bf16_t* vt = (const bf16_t*)(p.ws + WS_VT); float* ymem = (float*)(p.ws + WS_YMEM);
    const int tid = threadIdx.x, wv = tid >> 6, lane = tid & 63;
    float* qs = sm + wv * 384; float* ps = qs + 128;
    for (int it = blockIdx.x; it < M / 2; it += gridDim.x) {
        const int t = it * 2 + (wv >> 2), hd = wv & 3, b = t / SEQ;
        qs[lane] = bf2f(hb[(size_t)t * INW + POOLW + 2 * LRUW + hd * 128 + lane]); qs[lane + 64] = bf2f(hb[(size_t)t * INW + POOLW + 2 * LRUW + hd * 128 + lane + 64]);
        __syncthreads();
        float sc[4];
#pragma unroll
        for (int j = 0; j < 4; ++j) { const int key = lane + 64 * j; const bf16_t* kr = kb + ((size_t)(b * 4 + hd) * MEMLEN + key) * 128; float s = 0.f;
            for (int d = 0; d < 128; ++d) s = fmaf(qs[d], bf2f(kr[d]), s);
            sc[j] = s * 0.08838834764831845f; }
        const float mx = wave_max(fmaxf(fmaxf(sc[0], sc[1]), fmaxf(sc[2], sc[3])));
        float e[4], es = 0.f;
#pragma unroll
        for (int j = 0; j < 4; ++j) { e[j] = __expf(sc[j] - mx); es += e[j]; }
        const float inv = 1.f / wave_sum(es);
#pragma unroll
        for (int j = 0; j < 4; ++j) ps[lane + 64 * j] = e[j] * inv;
        __syncthreads();
#pragma unroll
        for (int q = 0; q < 2; ++q) { const int d = lane + 64 * q; const bf16_t* vr = vt + ((size_t)(b * 4 + hd) * 128 + d) * MEMLEN; float o = 0.f;
            for (int key = 0; key < MEMLEN; ++key) o = fmaf(ps[key], bf2f(vr[permkey(key)]), o);
            ymem[(size_t)t * MEMW + hd * 128 + d] = o; }
        __syncthreads();
    }
}
DEVI void s2e_norm(const P& p, float* sm) {
    const float* ypool = (const float*)(p.ws + WS_YPOOL); const float* ylru = (const float*)(p.ws + WS_YLRU); const float* ymem = (const float*)(p.ws + WS_YMEM);
    const float* g = p.in[I_MIXG]; bf16_t* mix = (bf16_t*)(p.ws + WS_MIX);
    const int tid = threadIdx.x, wv = tid >> 6, lane = tid & 63;
    for (int t = blockIdx.x; t < M; t += gridDim.x) {
        const float a = ypool[(size_t)t * POOLW + tid], b0 = ylru[(size_t)t * LRUW + tid], b1 = ylru[(size_t)t * LRUW + tid + NT], c = ymem[(size_t)t * MEMW + tid];
        const float s0 = wave_sum(a * a), s1 = wave_sum(b0 * b0 + b1 * b1), s2 = wave_sum(c * c);
        if (lane == 0) { sm[wv] = s0; sm[8 + wv] = s1; sm[16 + wv] = s2; }
        __syncthreads();
        float t0 = 0.f, t1 = 0.f, t2 = 0.f;
#pragma unroll
        for (int i = 0; i < 8; ++i) { t0 += sm[i]; t1 += sm[8 + i]; t2 += sm[16 + i]; }
        const float r0 = rsqrtf(t0 / POOLW + EPS), r1 = rsqrtf(t1 / LRUW + EPS), r2 = rsqrtf(t2 / MEMW + EPS);
        bf16_t* mr = mix + (size_t)t * MIXW;
        mr[tid] = f2bf(a * r0 * g[tid]); mr[POOLW + tid] = f2bf(b0 * r1 * g[POOLW + tid]); mr[POOLW + NT + tid] = f2bf(b1 * r1 * g[POOLW + NT + tid]);
        mr[POOLW + LRUW + tid] = f2bf(c * r2 * g[POOLW + LRUW + tid]);
        __syncthreads();
    }
}
DEVI void s3_outproj(const P& p, float* sm) {
    const float* x = p.in[I_X]; const float* w = p.in[I_WOUT]; const bf16_t* mix = (const bf16_t*)(p.ws + WS_MIX); float* z = p.out;
    const int ntn = D / 64, nt = (M / 128) * ntn;
    for (int it = blockIdx.x; it < nt; it += gridDim.x) {
        const int m0 = (it / ntn) * 128, n0 = (it % ntn) * 64;
        auto al = [&](int r, int k) { return bf2f(mix[(size_t)r * MIXW + k]); };
        auto bl = [&](int k, int n) { return w[(size_t)k * D + n]; };
        auto ep = [&](int r, int n, float v, float) { z[(size_t)r * D + n] = fmaf(ALPHA, x[(size_t)r * D + n], v); };
        sgemm_tile<false>(m0, n0, MIXW, al, bl, bl, ep, sm);
    }
}
DEVI void s4a_route(const P& p, float*) {
    const float* z = p.out; bf16_t* x1b = (bf16_t*)(p.ws + WS_X1B);
    const float* g1 = p.in[I_LN1G]; const float* b1 = p.in[I_LN1B]; const float* wg = p.in[I_WGROUP]; const float* bg = p.in[I_BGROUP]; const float* wf = p.in[I_WFINE]; const float* bfine = p.in[I_BFINE];
    int* cnt = (int*)(p.ws + WS_CTL) + CW_CNT; int* asg_e = (int*)(p.ws + WS_ASG_E); int* asg_s = (int*)(p.ws + WS_ASG_S); float* asg_w = (float*)(p.ws + WS_ASG_W);
    const int tid = threadIdx.x, wv = tid >> 6, lane = tid & 63;
    for (int t = blockIdx.x * 8 + wv; t < M; t += gridDim.x * 8) {
        float v[32]; float s = 0.f;
#pragma unroll
        for (int j = 0; j < 8; ++j) { const float4 q = *(const float4*)(z + (size_t)t * D + j * 256 + lane * 4); v[4 * j] = q.x; v[4 * j + 1] = q.y; v[4 * j + 2] = q.z; v[4 * j + 3] = q.w; s += (q.x + q.y) + (q.z + q.w); }
        const float mean = wave_sum(s) * (1.f / D); float s2 = 0.f;
#pragma unroll
        for (int i = 0; i < 32; ++i) { v[i] -= mean; s2 = fmaf(v[i], v[i], s2); }
        const float rstd = rsqrtf(wave_sum(s2) * (1.f / D) + EPS);
#pragma unroll
        for (int j = 0; j < 8; ++j) {
#pragma unroll
            for (int i = 0; i < 4; ++i) { const int k = j * 256 + lane * 4 + i; v[4 * j + i] = v[4 * j + i] * rstd * g1[k] + b1[k]; }
            ushort4 o; o.x = f2bf(v[4 * j]); o.y = f2bf(v[4 * j + 1]); o.z = f2bf(v[4 * j + 2]); o.w = f2bf(v[4 * j + 3]);
            *(ushort4*)(x1b + (size_t)t * D + j * 256 + lane * 4) = o; }
        float lg[4], lf[32];
#pragma unroll
        for (int o = 0; o < 4; ++o) { float a = 0.f;
#pragma unroll
            for (int j = 0; j < 8; ++j)
#pragma unroll
                for (int i = 0; i < 4; ++i) a = fmaf(v[4 * j + i], wg[(size_t)(j * 256 + lane * 4 + i) * NG + o], a);
            lg[o] = wave_sum(a) + bg[o]; }
#pragma unroll
        for (int o = 0; o < 32; ++o) { float a = 0.f;
#pragma unroll
            for (int j = 0; j < 8; ++j)
#pragma unroll
                for (int i = 0; i < 4; ++i) a = fmaf(v[4 * j + i], wf[(size_t)(j * 256 + lane * 4 + i) * NE + o], a);
            lf[o] = wave_sum(a); }
        int gi = 0; float gm = lg[0];
#pragma unroll
        for (int o = 1; o < 4; ++o) if (lg[o] > gm) { gm = lg[o]; gi = o; }
        float ge = 0.f;
#pragma unroll
        for (int o = 0; o < 4; ++o) ge += __expf(lg[o] - gm);
        const float gp = 1.f / ge;
        float fs[8];
#pragma unroll
        for (int j = 0; j < 8; ++j) { float q = lf[j];
#pragma unroll
            for (int o = 1; o < 4; ++o) q = (gi == o) ? lf[o * 8 + j] : q;
            fs[j] = q + bfine[gi * 8 + j]; }
        int i0 = 0; float l0 = fs[0];
#pragma unroll
        for (int j = 1; j < 8; ++j) if (fs[j] > l0) { l0 = fs[j]; i0 = j; }
        int i1 = -1; float l1 = -3.0e38f;
#pragma unroll
        for (int j = 0; j < 8; ++j) if (j != i0 && fs[j] > l1) { l1 = fs[j]; i1 = j; }
        const float e1 = __expf(l1 - l0), w0 = gp / (1.f + e1), w1 = gp * e1 / (1.f + e1);
        if (lane == 0) {
            const int ea = gi * 8 + i0, eb = gi * 8 + i1;
            const int sa = atomicAdd(&cnt[ea], 1), sb = atomicAdd(&cnt[eb], 1);
            asg_e[2 * t] = ea; asg_e[2 * t + 1] = eb; asg_s[2 * t] = sa; asg_s[2 * t + 1] = sb; asg_w[2 * t] = w0; asg_w[2 * t + 1] = w1;
        }
    }
}
DEVI void load_offs(const P& p, int* offs) {
    const int* cnt = (const int*)(p.ws + WS_CTL) + CW_CNT;
    if (threadIdx.x == 0) { int o = 0; for (int e = 0; e < NE; ++e) { offs[e] = o; o += (cnt[e] + 255) / 256 * 256; } offs[NE] = o; }
    __syncthreads();
}
DEVI void s4b_gather(const P& p, float* sm) {
    int* offs = (int*)sm; load_offs(p, offs);
    const bf16_t* x1b = (const bf16_t*)(p.ws + WS_X1B); bf16_t* xg = (bf16_t*)(p.ws + WS_XG);
    const int* asg_e = (const int*)(p.ws + WS_ASG_E); const int* asg_s = (const int*)(p.ws + WS_ASG_S); int* asg_r = (int*)(p.ws + WS_ASG_R);
    const int tid = threadIdx.x, wv = tid >> 6, lane = tid & 63;
    for (int t = blockIdx.x * 8 + wv; t < M; t += gridDim.x * 8) {
        const uint4 a = *(const uint4*)(x1b + (size_t)t * D + lane * 8), b = *(const uint4*)(x1b + (size_t)t * D + 512 + lane * 8),
                    c = *(const uint4*)(x1b + (size_t)t * D + 1024 + lane * 8), d = *(const uint4*)(x1b + (size_t)t * D + 1536 + lane * 8);
#pragma unroll
        for (int k = 0; k < 2; ++k) { const int row = offs[asg_e[2 * t + k]] + asg_s[2 * t + k]; bf16_t* dst = xg + (size_t)row * D;
            *(uint4*)(dst + lane * 8) = a; *(uint4*)(dst + 512 + lane * 8) = b; *(uint4*)(dst + 1024 + lane * 8) = c; *(uint4*)(dst + 1536 + lane * 8) = d;
            if (lane == 0) asg_r[2 * t + k] = row; }
    }
}
DEVI int expert_of_row(const int* offs, int row) { int e = 0; for (int i = 1; i < NE; ++i) if (row >= offs[i]) e = i; return e; }
DEVI float silu_(float v) { return v / (1.f + __expf(-v)); }
DEVI void s5_expert1(const P& p, float* sm) {
    int* offs = (int*)(sm + 8192); load_offs(p, offs);
    const bf16_t* xg = (const bf16_t*)(p.ws + WS_XG); bf16_t* hd = (bf16_t*)(p.ws + WS_HD);
    const int ntn = FF / 64, nt = (offs[NE] / 128) * ntn;
    for (int it = blockIdx.x; it < nt; it += gridDim.x) {
        const int m0 = (it / ntn) * 128, n0 = (it % ntn) * 64, e = expert_of_row(offs, m0);
        const float* wgt = p.in[I_WGATE] + (size_t)e * D * FF; const float* wup = p.in[I_WUP] + (size_t)e * D * FF;
        auto al = [&](int r, int k) { return bf2f(xg[(size_t)r * D + k]); };
        auto bl = [&](int k, int n) { return wgt[(size_t)k * FF + n]; };
        auto bl2 = [&](int k, int n) { return wup[(size_t)k * FF + n]; };
        auto ep = [&](int r, int n, float g, float u) { hd[(size_t)r * FF + n] = f2bf(silu_(g) * u); };
        sgemm_tile<true>(m0, n0, D, al, bl, bl2, ep, sm);
    }
}
DEVI void s6_expert2(const P& p, float* sm) {
    int* offs = (int*)(sm + 8192); load_offs(p, offs);
    const bf16_t* hd = (const bf16_t*)(p.ws + WS_HD); bf16_t* yb = (bf16_t*)(p.ws + WS_YB);
    const int ntn = D / 64, nt = (offs[NE] / 128) * ntn;
    for (int it = blockIdx.x; it < nt; it += gridDim.x) {
        const int m0 = (it / ntn) * 128, n0 = (it % ntn) * 64, e = expert_of_row(offs, m0);
        const float* wd = p.in[I_WDOWN] + (size_t)e * FF * D;
        auto al = [&](int r, int k) { return bf2f(hd[(size_t)r * FF + k]); };
        auto bl = [&](int k, int n) { return wd[(size_t)k * D + n]; };
        auto ep = [&](int r, int n, float v, float) { yb[(size_t)r * D + n] = f2bf(v); };
        sgemm_tile<false>(m0, n0, FF, al, bl, bl, ep, sm);
    }
}
DEVI void s7_final(const P& p, float*) {
    const bf16_t* x1b = (const bf16_t*)(p.ws + WS_X1B); const bf16_t* yb = (const bf16_t*)(p.ws + WS_YB);
    const int* asg_r = (const int*)(p.ws + WS_ASG_R); const float* asg_w = (const float*)(p.ws + WS_ASG_W);
    const float* g2 = p.in[I_LN2G]; const float* b2 = p.in[I_LN2B]; float* out = p.out;
    const int tid = threadIdx.x, wv = tid >> 6, lane = tid & 63;
    for (int t = blockIdx.x * 8 + wv; t < M; t += gridDim.x * 8) {
        const int r0 = asg_r[2 * t], r1 = asg_r[2 * t + 1]; const float w0 = asg_w[2 * t], w1 = asg_w[2 * t + 1];
        float v[32]; float s = 0.f;
#pragma unroll
        for (int j = 0; j < 8; ++j) { const int k = j * 256 + lane * 4;
            const ushort4 a = *(const ushort4*)(x1b + (size_t)t * D + k), y0 = *(const ushort4*)(yb + (size_t)r0 * D + k), y1 = *(const ushort4*)(yb + (size_t)r1 * D + k);
            v[4 * j] = ALPHA * bf2f(a.x) + w0 * bf2f(y0.x) + w1 * bf2f(y1.x); v[4 * j + 1] = ALPHA * bf2f(a.y) + w0 * bf2f(y0.y) + w1 * bf2f(y1.y);
            v[4 * j + 2] = ALPHA * bf2f(a.z) + w0 * bf2f(y0.z) + w1 * bf2f(y1.z); v[4 * j + 3] = ALPHA * bf2f(a.w) + w0 * bf2f(y0.w) + w1 * bf2f(y1.w);
            s += (v[4 * j] + v[4 * j + 1]) + (v[4 * j + 2] + v[4 * j + 3]); }
        const float mean = wave_sum(s) * (1.f / D); float s2 = 0.f;
#pragma unroll
        for (int i = 0; i < 32; ++i) { v[i] -= mean; s2 = fmaf(v[i], v[i], s2); }
        const float rstd = rsqrtf(wave_sum(s2) * (1.f / D) + EPS);
#pragma unroll
        for (int j = 0; j < 8; ++j) { const int k = j * 256 + lane * 4; const float4 g = *(const float4*)(g2 + k), b = *(const float4*)(b2 + k);
            float4 o; o.x = v[4 * j] * rstd * g.x + b.x; o.y = v[4 * j + 1] * rstd * g.y + b.y; o.z = v[4 * j + 2] * rstd * g.z + b.z; o.w = v[4 * j + 3] * rstd * g.w + b.w;
            *(float4*)(out + (size_t)t * D + k) = o; }
    }
}

constexpr int NSTAGE = 12;
template <int S> DEVI void run_stage(const P& p, float* sm) {
    if (S == 0) s1_inproj(p, sm);
    if (S == 1) s2a_pool(p, sm);
    if (S == 2) s2b_lru(p, sm);
    if (S == 3) s2c_scan(p, sm);
    if (S == 4) s2d_attn(p, sm);
    if (S == 5) s2e_norm(p, sm);
    if (S == 6) s3_outproj(p, sm);
    if (S == 7) s4a_route(p, sm);
    if (S == 8) s4b_gather(p, sm);
    if (S == 9) s5_expert1(p, sm);
    if (S == 10) s6_expert2(p, sm);
    if (S == 11) s7_final(p, sm);
}

constexpr int LDS_BYTES = 144 * 1024;
__global__ void __launch_bounds__(NT, 2) mega_fwd(P p) {
    extern __shared__ __attribute__((aligned(16))) unsigned char lds[];
    float* sm = (float*)lds;
    cg::grid_group grid = cg::this_grid();
    run_stage<0>(p, sm); grid.sync();
    run_stage<1>(p, sm); run_stage<2>(p, sm); run_stage<4>(p, sm); grid.sync();
    run_stage<3>(p, sm); grid.sync();
    run_stage<5>(p, sm); grid.sync();
    run_stage<6>(p, sm); grid.sync();
    run_stage<7>(p, sm); grid.sync();
    run_stage<8>(p, sm); grid.sync();
    run_stage<9>(p, sm); grid.sync();
    run_stage<10>(p, sm); grid.sync();
    run_stage<11>(p, sm);
}
template <int S> __global__ void __launch_bounds__(NT, 2) stage_kernel(P p) {
    extern __shared__ __attribute__((aligned(16))) unsigned char lds[];
    run_stage<S>(p, (float*)lds);
}

extern "C" void kernel_launch(void* const* d_in, const int* in_sizes, int n_in, void* d_out, int out_size, void* d_ws, size_t ws_size, hipStream_t stream) {
    static int grid = 0;
    if (grid == 0) {
        if (n_in != 26 || out_size != M * D || ws_size < WS_END) { fprintf(stderr, "kernel_launch: unexpected shapes: n_in %d out %d ws %zu (need %zu)\n", n_in, out_size, ws_size, (size_t)WS_END); grid = -1; return; }
        int dev = 0, cus = 0, per_cu = 0;
        (void)hipGetDevice(&dev); (void)hipDeviceGetAttribute(&cus, hipDeviceAttributeMultiprocessorCount, dev);
        (void)hipFuncSetAttribute((const void*)mega_fwd, hipFuncAttributeMaxDynamicSharedMemorySize, LDS_BYTES);
        (void)hipOccupancyMaxActiveBlocksPerMultiprocessor(&per_cu, (const void*)mega_fwd, NT, LDS_BYTES);
        if (per_cu < 1) { fprintf(stderr, "kernel_launch: occupancy query says %d blocks per CU\n", per_cu); per_cu = 1; }
        grid = cus;
        fprintf(stderr, "kernel_launch: cus %d per_cu %d grid %d ws %zu\n", cus, per_cu, grid, ws_size);
    }
    if (grid < 0) return;
    (void)hipMemsetAsync((char*)d_ws + WS_CTL, 0, 1 * MiB, stream);
    P p{};
    for (int i = 0; i < 26; ++i) p.in[i] = (const float*)d_in[i];
    p.out = (float*)d_out; p.ws = (unsigned char*)d_ws;
#if ONE_LAUNCH
    void* args[] = {&p};
    hipError_t e = hipLaunchCooperativeKernel((const void*)mega_fwd, dim3(grid), dim3(NT), args, LDS_BYTES, stream);
    if (e != hipSuccess) fprintf(stderr, "cooperative launch failed: %s (grid %d)\n", hipGetErrorString(e), grid);
#else
    const int g2 = grid * 1;
#define LAUNCH(S) do { hipFuncSetAttribute((const void*)stage_kernel<S>, hipFuncAttributeMaxDynamicSharedMemorySize, LDS_BYTES); hipLaunchKernelGGL(stage_kernel<S>, dim3(g2), dim3(NT), LDS_BYTES, stream, p); } while (0)
    LAUNCH(0); LAUNCH(1); LAUNCH(2); LAUNCH(4); LAUNCH(3); LAUNCH(5); LAUNCH(6); LAUNCH(7); LAUNCH(8); LAUNCH(9); LAUNCH(10); LAUNCH(11);
#endif
}
```

```cpp
#include <hip/hip_runtime.h>
#include <hip/hip_cooperative_groups.h>
#include <cstdio>
#include <cstdint>
namespace cg = cooperative_groups;

#define DEVI __device__ __forceinline__
__device__ __forceinline__ int opaque_tid() { int t = threadIdx.x; asm volatile("" : "+v"(t)); return t; }
#ifndef NAIVE_KV
#define NAIVE_KV 0
#endif
#ifndef NAIVE_INPROJ
#define NAIVE_INPROJ 0
#endif
#ifndef ONE_LAUNCH
#define ONE_LAUNCH 1
#endif

constexpr int D = 2048, BATCH = 2, SEQ = 8192, M = BATCH * SEQ, MEMLEN = 256;
constexpr int POOLW = 512, LRUW = 1024, MEMW = 512, MIXW = 2048, INW = 3072;
constexpr int NG = 4, EPG = 8, NE = 32, FF = 1024;
constexpr float ALPHA = 1.189207115002721f;
constexpr float EPS = 1e-5f;
constexpr int NT = 512;

constexpr size_t MiB = 1u << 20;
constexpr size_t WS_CTL = 0;
constexpr size_t WS_KB = 1 * MiB, WS_VT = 1 * MiB + 512 * 1024;
constexpr size_t WS_ASG_E = 2 * MiB, WS_ASG_S = WS_ASG_E + 128 * 1024, WS_ASG_W = WS_ASG_S + 128 * 1024, WS_ASG_R = WS_ASG_W + 128 * 1024;
constexpr size_t WS_AGG = 4 * MiB;
constexpr size_t WS_WPT = 8 * MiB, WS_WAT = WS_WPT + 128 * 1024, WS_WXT = WS_WAT + 256 * 1024;
constexpr size_t WS_HC = 424 * MiB;
constexpr size_t WS_WGU = 16 * MiB;
constexpr size_t WS_WD = 272 * MiB;
constexpr size_t WS_WIN = 400 * MiB;
constexpr size_t WS_WOUT = 412 * MiB;
constexpr size_t WS_XB = 424 * MiB;
constexpr size_t WS_X1B = 424 * MiB;
constexpr size_t WS_HB = 488 * MiB;
constexpr size_t WS_MIX = 584 * MiB;
constexpr size_t WS_XG = 488 * MiB;
constexpr size_t WS_HD = 652 * MiB;
constexpr size_t WS_YB = 488 * MiB;
constexpr size_t WS_TMP = 652 * MiB;
constexpr size_t WS_YPOOL = WS_TMP, WS_AS = WS_TMP + 32 * MiB, WS_BS = WS_AS + 64 * MiB, WS_YLRU = WS_BS + 64 * MiB, WS_YMEM = WS_YLRU + 64 * MiB;
constexpr size_t WS_END = WS_YMEM + 32 * MiB;
constexpr int ROWS_MAX = 2 * M + NE * 256;
constexpr int CW_CNT = 64;

typedef unsigned short bf16_t;
DEVI float bf2f(bf16_t v) { return __uint_as_float(((unsigned)v) << 16); }
DEVI bf16_t f2bf(float f) { unsigned u = __float_as_uint(f); return (bf16_t)((u + 0x7fffu + ((u >> 16) & 1u)) >> 16); }

struct P { const float* in[26]; float* out; unsigned char* ws; };
enum { I_X = 0, I_MEM, I_WIN, I_WPOOL, I_PSCALE, I_CONVW, I_CONVB, I_WA, I_BA, I_WX, I_BX, I_LAM, I_WKV, I_MIXG, I_WOUT, I_LN1G, I_LN1B,
       I_WGROUP, I_BGROUP, I_WFINE, I_BFINE, I_WGATE, I_WUP, I_WDOWN, I_LN2G, I_LN2B };

DEVI float wave_sum(float v) {
#pragma unroll
    for (int o = 1; o < 64; o <<= 1) v += __shfl_xor(v, o);
    return v;
}
DEVI float wave_max(float v) {
#pragma unroll
    for (int o = 1; o < 64; o <<= 1) v = fmaxf(v, __shfl_xor(v, o));
    return v;
}
DEVI int permkey(int key) { const int k = key & 31; return (key & ~31) | (k & 16) | (((k >> 2) & 1) << 3) | (((k >> 3) & 1) << 2) | (k & 3); }

namespace pg8 {
#define PG8_LAS __attribute__((address_space(3)))
typedef unsigned short bf16_t;
typedef short bf16x8 __attribute__((ext_vector_type(8)));
typedef float f32x4 __attribute__((ext_vector_type(4)));
typedef unsigned u32x4 __attribute__((ext_vector_type(4)));
constexpr int BM = 256, BK = 64, HALF = 128, HTB = HALF * BK * 2  , STAGE_BYTES = 8 * HTB, NXCD = 8, WGM = 8;

__host__ __device__ __forceinline__ int lds_byte(int r, int c) { const int st = (r >> 4) * 2 + (c >> 5), rr = r & 15, cc = c & 31, ob = rr * 64 + cc * 2; return st * 1024 + (ob ^ (((ob >> 9) & 1) << 5)); }
__host__ __device__ __forceinline__ void stage_rc(int b, int& R, int& C) { const int st = b / 1024, sb = b % 1024, swz = sb ^ (((sb >> 9) & 1) << 5); R = (st >> 1) * 16 + swz / 64; C = (st & 1) * 32 + (swz % 64) / 2; }
__host__ __device__ __forceinline__ int perm32(int rho) { const int n = rho >> 4, i = rho & 15; return 8 * (i >> 2) + 4 * n + (i & 3); }

struct Unit { int pm, pn; };
struct Gemm { const bf16_t* A; const bf16_t* Bt; int M, N, K; };

struct StaticOrder {
    int nM, nN, nwg, G, c;
    __host__ __device__ void init(int M, int N, int G_, int c_) { nM = M / BM; nN = N / BM; nwg = nM * nN; G = G_; c = c_; }
    __host__ __device__ bool next(int i, Unit& u) const {
        const long L = (long)i * G + c; if (L >= nwg) return false;
        int wgid = (int)L; { const int q = nwg / NXCD, r = nwg % NXCD, xcd = wgid % NXCD, off = wgid / NXCD; wgid = (xcd < r ? xcd * (q + 1) : r * (q + 1) + (xcd - r) * q) + off; }
        const int nig = WGM * nN, gid = wgid / nig, fm = gid * WGM, gsz = (nM - fm) < WGM ? (nM - fm) : WGM;
        u.pm = fm + ((wgid % nig) % gsz); u.pn = (wgid % nig) / gsz; return true;
    }
    __device__ __forceinline__ void a_ready(const Unit&) const {}
    __device__ __forceinline__ void done(const Unit&) const {}
};

__device__ __forceinline__ unsigned cvt_pk_bf16(float lo, float hi) { unsigned r; asm volatile("v_cvt_pk_bf16_f32 %0, %1, %2" : "=v"(r) : "v"(lo), "v"(hi)); return r; }
typedef float f32x2 __attribute__((ext_vector_type(2)));
__device__ __forceinline__ f32x2 gelu_pk(f32x2 v) {
    const f32x2 av = __builtin_elementwise_abs(v), d = av * 0.2316418882f + 1.0f;
    f32x2 t; t.x = __builtin_amdgcn_rcpf(d.x); t.y = __builtin_amdgcn_rcpf(d.y);
    f32x2 q = t * 0.5307027145f + (-0.7265760135f); q = q * t + 0.7107068705f; q = q * t + (-0.142248368f); q = q * t + 0.127414796f; q = q * t;
    const f32x2 s = (v * v) * (-0.72134752044f);
    f32x2 e; e.x = __builtin_amdgcn_exp2f(s.x); e.y = __builtin_amdgcn_exp2f(s.y);
    const f32x2 m = v * (q * e), r = v - m;
    f32x2 o; o.x = v.x < 0.f ? m.x : r.x; o.y = v.y < 0.f ? m.y : r.y; return o;
}

template <int ACT  > struct EpiBf16 {
    static constexpr bool PERM = true, AFTER_DRAIN = false; static_assert(ACT == 0 || ACT == 1, "EpiBf16: ACT is 0 (none) or 1 (gelu_pk)");
    bf16_t* O; int ldc; const float* bias; int split_cols; size_t split_stride; float scale0;
    __device__ __forceinline__ void operator()(const f32x4 (&acc)[2][2][4][2], const Unit& u, int wr, int wc, int fr, int fq) const {
        const int row0 = u.pm * BM + wr * 64 + fr; int colt = u.pn * BM; bf16_t* base = O;
        float sc = 1.f; if (split_cols) { const int t = colt / split_cols; base += (size_t)t * split_stride; colt -= t * split_cols; if (t == 0) sc = scale0; }
        const int col0 = colt + wc * 32 + 8 * fq, bcol0 = u.pn * BM + wc * 32 + 8 * fq;
        f32x4 bv[2][2];
#pragma unroll
        for (int bj = 0; bj < 2; ++bj)
#pragma unroll
            for (int n = 0; n < 2; ++n) bv[bj][n] = bias ? *(const f32x4*)(bias + bcol0 + bj * HALF + 4 * n) : (f32x4){0.f, 0.f, 0.f, 0.f};
#pragma unroll
        for (int ai = 0; ai < 2; ++ai)
#pragma unroll
            for (int m = 0; m < 4; ++m) { bf16_t* rowp = base + (size_t)(row0 + ai * HALF + m * 16) * ldc + col0;
#pragma unroll
                for (int bj = 0; bj < 2; ++bj) { f32x4 v0 = acc[ai][bj][m][0] + bv[bj][0], v1 = acc[ai][bj][m][1] + bv[bj][1];
                    if (ACT == 1) { f32x2 a = gelu_pk((f32x2){v0[0], v0[1]}), b = gelu_pk((f32x2){v0[2], v0[3]}), c = gelu_pk((f32x2){v1[0], v1[1]}), d = gelu_pk((f32x2){v1[2], v1[3]});
                        v0 = (f32x4){a.x, a.y, b.x, b.y}; v1 = (f32x4){c.x, c.y, d.x, d.y}; }
                    v0 = v0 * sc; v1 = v1 * sc; u32x4 w; w.x = cvt_pk_bf16(v0[0], v0[1]); w.y = cvt_pk_bf16(v0[2], v0[3]); w.z = cvt_pk_bf16(v1[0], v1[1]); w.w = cvt_pk_bf16(v1[2], v1[3]);
                    *(u32x4*)(rowp + bj * HALF) = w; } }
    }
};

template <class Epi, class Sched, bool ALIGN_EPI = false, bool SP2 = false>
__device__ __forceinline__ void gemm_phase(PG8_LAS unsigned char* lds, const Gemm g, const Sched& S, const Epi& E) {
    const int tid = opaque_tid(), wid = __builtin_amdgcn_readfirstlane(tid >> 6), lane = tid & 63, wr = wid >> 2, wc = wid & 3, fr = lane & 15, fq = lane >> 4;
    const int K = g.K, nt = K / BK;
    unsigned voffA[2], voffB[2];
#pragma unroll
    for (int i = 0; i < 2; ++i) { int R, C; stage_rc(tid * 16 + i * 8192, R, C); const int Rb = Epi::PERM ? ((R & ~31) + perm32(R & 31)) : R;
        voffA[i] = (unsigned)(R * K + C) * 2u; voffB[i] = (unsigned)(Rb * K + C) * 2u; }
    const size_t kstep = (size_t)(BK * 2);
    const size_t hstep = (size_t)HALF * K * 2;
    const size_t tstep = 2 * hstep;
    const unsigned ldsw = (unsigned)wid * 1024u;
    const int aoff = lds_byte(wr * 64 + fr, fq * 8), boff = lds_byte(wc * 32 + fr, fq * 8);
#define PG8_SA(b, h) (((b) * 2 + (h)) * HTB)
#define PG8_SB(b, h) ((4 + (b) * 2 + (h)) * HTB)
#define PG8_STAGE(bufoff, gbase, voff) do { _Pragma("unroll") for (int _i = 0; _i < 2; ++_i) \
        __builtin_amdgcn_global_load_lds((const unsigned*)((const char*)(gbase) + (voff)[_i]), (PG8_LAS unsigned*)(lds + (bufoff) + ldsw + _i * 8192), 16, 0, 0); } while (0)
#define PG8_LDA(dst, b, h) do { _Pragma("unroll") for (int m = 0; m < 4; ++m) _Pragma("unroll") for (int k = 0; k < 2; ++k) dst[m][k] = *(const PG8_LAS bf16x8*)(lds + PG8_SA(b, h) + aoff + m * 2048 + k * 1024); } while (0)
#define PG8_LDB(dst, b, h) do { _Pragma("unroll") for (int n = 0; n < 2; ++n) _Pragma("unroll") for (int k = 0; k < 2; ++k) dst[n][k] = *(const PG8_LAS bf16x8*)(lds + PG8_SB(b, h) + boff + n * 2048 + k * 1024); } while (0)
#define PG8_MMA(ai, bj, At, Bt) do { __builtin_amdgcn_s_setprio(1); _Pragma("unroll") for (int m = 0; m < 4; ++m) _Pragma("unroll") for (int n = 0; n < 2; ++n) _Pragma("unroll") for (int k = 0; k < 2; ++k) \
        acc[ai][bj][m][n] = __builtin_amdgcn_mfma_f32_16x16x32_bf16(Bt[n][k], At[m][k], acc[ai][bj][m][n], 0, 0, 0); __builtin_amdgcn_s_setprio(0); } while (0)
#define PG8_WAIT_V(n) asm volatile("s_waitcnt vmcnt(" #n ")" ::: "memory")
#define PG8_WAIT_L(n) asm volatile("s_waitcnt lgkmcnt(" #n ")" ::: "memory")
#define PG8_BAR __builtin_amdgcn_s_barrier()
#define PG8_SCHED __builtin_amdgcn_sched_barrier(0)
    Unit cur, nxt; int ui = 0;
    if (!S.next(0, cur)) return;
    f32x4 acc[2][2][4][2];
#pragma unroll
    for (int a = 0; a < 2; ++a)
#pragma unroll
        for (int b = 0; b < 2; ++b)
#pragma unroll
            for (int m = 0; m < 4; ++m)
#pragma unroll
                for (int n = 0; n < 2; ++n) acc[a][b][m][n] = (f32x4){0.f, 0.f, 0.f, 0.f};
    bf16x8 At[4][2], B0[2][2], B1[2][2];
    const char* cA = (const char*)g.A + (size_t)cur.pm * tstep; const char* cB = (const char*)g.Bt + (size_t)cur.pn * tstep;
    S.a_ready(cur);
    if constexpr (SP2) {
        PG8_STAGE(PG8_SB(0, 0), cB, voffB); PG8_STAGE(PG8_SB(0, 1), cB + hstep, voffB); PG8_STAGE(PG8_SA(0, 0), cA, voffA); PG8_STAGE(PG8_SA(0, 1), cA + hstep, voffA);
        if (wr == 1) PG8_BAR;
        PG8_WAIT_V(2); PG8_BAR;
        PG8_STAGE(PG8_SB(1, 0), cB + kstep, voffB); PG8_STAGE(PG8_SA(1, 0), cA + kstep, voffA); PG8_STAGE(PG8_SB(1, 1), cB + hstep + kstep, voffB);
        PG8_WAIT_V(6); PG8_BAR;
    } else {
        PG8_STAGE(PG8_SB(0, 0), cB, voffB); PG8_STAGE(PG8_SA(0, 0), cA, voffA); PG8_STAGE(PG8_SB(0, 1), cB + hstep, voffB); PG8_STAGE(PG8_SA(0, 1), cA + hstep, voffA);
        if (wr == 1) PG8_BAR;
        PG8_WAIT_V(4); PG8_BAR;
        PG8_STAGE(PG8_SB(1, 0), cB + kstep, voffB); PG8_STAGE(PG8_SA(1, 0), cA + kstep, voffA); PG8_STAGE(PG8_SB(1, 1), cB + hstep + kstep, voffB);
        PG8_WAIT_V(6); PG8_BAR;
    }
    for (;;) {
        const bool has_next = S.next(ui + 1, nxt);
        const char* nA = has_next ? (const char*)g.A + (size_t)nxt.pm * tstep : cA; const char* nB = has_next ? (const char*)g.Bt + (size_t)nxt.pn * tstep : cB;
        for (int t = 0; t < nt; t += 2) {
            const bool last = (t == nt - 2);
            const char* a1 = cA + (size_t)(t + 1) * kstep;
            const char* a2 = last ? nA : cA + (size_t)(t + 2) * kstep; const char* b2 = last ? nB : cB + (size_t)(t + 2) * kstep;
            const char* a3 = a2 + kstep; const char* b3 = b2 + kstep;
            if (last && has_next) S.a_ready(nxt);
            if constexpr (SP2) {
            PG8_LDB(B0, 0, 0); PG8_LDB(B1, 0, 1); PG8_SCHED; PG8_LDA(At, 0, 0); PG8_STAGE(PG8_SA(1, 1), a1 + hstep, voffA);
            PG8_WAIT_V(8); PG8_WAIT_L(0); PG8_BAR; PG8_MMA(0, 0, At, B0); PG8_MMA(0, 1, At, B1); PG8_BAR; PG8_SCHED;
            PG8_LDA(At, 0, 1); PG8_STAGE(PG8_SB(0, 0), b2, voffB); PG8_STAGE(PG8_SB(0, 1), b2 + hstep, voffB); PG8_STAGE(PG8_SA(0, 0), a2, voffA);
            PG8_WAIT_V(8); PG8_WAIT_L(0); PG8_BAR; PG8_MMA(1, 0, At, B0); PG8_MMA(1, 1, At, B1); PG8_BAR; PG8_SCHED;
            PG8_LDB(B0, 1, 0); PG8_LDB(B1, 1, 1); PG8_SCHED; PG8_LDA(At, 1, 0); PG8_STAGE(PG8_SA(0, 1), a2 + hstep, voffA);
            PG8_WAIT_V(8); PG8_WAIT_L(0); PG8_BAR; PG8_MMA(0, 0, At, B0); PG8_MMA(0, 1, At, B1); PG8_BAR; PG8_SCHED;
            PG8_LDA(At, 1, 1); PG8_STAGE(PG8_SB(1, 0), b3, voffB); PG8_STAGE(PG8_SB(1, 1), b3 + hstep, voffB); PG8_STAGE(PG8_SA(1, 0), a3, voffA);
            PG8_WAIT_V(8); PG8_WAIT_L(0); PG8_BAR; PG8_MMA(1, 0, At, B0); PG8_MMA(1, 1, At, B1); PG8_BAR; PG8_SCHED;
            } else {
            PG8_LDB(B0, 0, 0); PG8_SCHED; PG8_LDA(At, 0, 0); PG8_STAGE(PG8_SA(1, 1), a1 + hstep, voffA);
            PG8_WAIT_L(8); PG8_BAR; PG8_WAIT_L(0); PG8_MMA(0, 0, At, B0); PG8_BAR; PG8_SCHED;
            PG8_LDB(B1, 0, 1); PG8_STAGE(PG8_SB(0, 0), b2, voffB);
            PG8_BAR; PG8_WAIT_L(0); PG8_MMA(0, 1, At, B1); PG8_BAR;
            PG8_LDA(At, 0, 1); PG8_STAGE(PG8_SA(0, 0), a2, voffA);
            PG8_BAR; PG8_WAIT_L(0); PG8_MMA(1, 0, At, B0); PG8_BAR; PG8_SCHED;
            PG8_STAGE(PG8_SB(0, 1), b2 + hstep, voffB);
            PG8_WAIT_V(6); PG8_BAR; PG8_MMA(1, 1, At, B1); PG8_BAR;
            PG8_LDB(B0, 1, 0); PG8_SCHED; PG8_LDA(At, 1, 0); PG8_STAGE(PG8_SA(0, 1), a2 + hstep, voffA);
            PG8_WAIT_L(8); PG8_BAR; PG8_WAIT_L(0); PG8_MMA(0, 0, At, B0); PG8_BAR; PG8_SCHED;
            PG8_LDB(B1, 1, 1); PG8_STAGE(PG8_SB(1, 0), b3, voffB);
            PG8_BAR; PG8_WAIT_L(0); PG8_MMA(0, 1, At, B1); PG8_BAR;
            PG8_LDA(At, 1, 1); PG8_STAGE(PG8_SA(1, 0), a3, voffA);
            PG8_BAR; PG8_WAIT_L(0); PG8_MMA(1, 0, At, B0); PG8_BAR; PG8_SCHED;
            PG8_STAGE(PG8_SB(1, 1), b3 + hstep, voffB);
            PG8_WAIT_V(6); PG8_BAR; PG8_MMA(1, 1, At, B1); PG8_BAR;
            }
        }
        if constexpr (ALIGN_EPI) { if (wr == 0) PG8_BAR; }
        if constexpr (!Epi::AFTER_DRAIN) { E(acc, cur, wr, wc, fr, fq); S.done(cur); }
        if (!has_next) break;
#pragma unroll
        for (int a = 0; a < 2; ++a)
#pragma unroll
            for (int b = 0; b < 2; ++b)
#pragma unroll
                for (int m = 0; m < 4; ++m)
#pragma unroll
                    for (int n = 0; n < 2; ++n) acc[a][b][m][n] = (f32x4){0.f, 0.f, 0.f, 0.f};
        cur = nxt; cA = nA; cB = nB; ++ui;
        if constexpr (ALIGN_EPI) { if (wr == 1) PG8_BAR; }
    }
    PG8_WAIT_V(0);
    if constexpr (!ALIGN_EPI) { if (wr == 0) PG8_BAR; }
    PG8_BAR;
    if constexpr (Epi::AFTER_DRAIN) { E.fused(acc, cur, wr, wc, fr, fq, lds, wid, lane); S.done(cur); }
#undef PG8_SA
#undef PG8_SB
#undef PG8_STAGE
#undef PG8_LDA
#undef PG8_LDB
#undef PG8_MMA
#undef PG8_WAIT_V
#undef PG8_WAIT_L
#undef PG8_BAR
#undef PG8_SCHED
}
}


#define LAS __attribute__((address_space(3)))
typedef unsigned v4u __attribute__((ext_vector_type(4)));
typedef float f32x4 __attribute__((ext_vector_type(4)));
DEVI unsigned pk2(float lo, float hi) { return (unsigned)f2bf(lo) | ((unsigned)f2bf(hi) << 16); }
constexpr int NWAVES = NT / 64;

struct EpiZ {
    static constexpr bool PERM = false, AFTER_DRAIN = false;
    const float* x; float* z; int ldc;
    __device__ __forceinline__ void operator()(const pg8::f32x4 (&acc)[2][2][4][2], const pg8::Unit& u, int wr, int wc, int fr, int fq) const {
        const int row0 = u.pm * pg8::BM + wr * 64 + fr, col0 = u.pn * pg8::BM + wc * 32 + 4 * fq;
#pragma unroll
        for (int ai = 0; ai < 2; ++ai)
#pragma unroll
            for (int m = 0; m < 4; ++m) { const size_t off = (size_t)(row0 + ai * pg8::HALF + m * 16) * ldc + col0;
#pragma unroll
                for (int bj = 0; bj < 2; ++bj)
#pragma unroll
                    for (int n = 0; n < 2; ++n) { const pg8::f32x4 xv = *(const pg8::f32x4*)(x + off + bj * pg8::HALF + n * 16);
                        *(pg8::f32x4*)(z + off + bj * pg8::HALF + n * 16) = xv * ALPHA + acc[ai][bj][m][n]; } }
    }
};

DEVI void transpose_item(const float* W, int ldn, int k0, int n0, bf16_t* dst, int K, LAS float* scr, int lane) {
    const int r = lane >> 3, q = lane & 7;
    f32x4 v[8];
#pragma unroll
    for (int i = 0; i < 8; ++i) v[i] = *(const f32x4*)(W + (size_t)(k0 + i * 8 + r) * ldn + n0 + 4 * q);
#pragma unroll
    for (int i = 0; i < 8; ++i) { LAS float* s = scr + (i * 8 + r) * 33 + 4 * q; s[0] = v[i][0]; s[1] = v[i][1]; s[2] = v[i][2]; s[3] = v[i][3]; }
    asm volatile("s_waitcnt lgkmcnt(0)" ::: "memory");
    const int c = lane & 7;
#pragma unroll
    for (int j = 0; j < 4; ++j) { const int n = (lane >> 3) + 8 * j; const LAS float* s = scr + (8 * c) * 33 + n;
        v4u o; o.x = pk2(s[0 * 33], s[1 * 33]); o.y = pk2(s[2 * 33], s[3 * 33]); o.z = pk2(s[4 * 33], s[5 * 33]); o.w = pk2(s[6 * 33], s[7 * 33]);
        *(v4u*)(dst + (size_t)n * K + 8 * c) = o; }
    asm volatile("s_waitcnt lgkmcnt(0)" ::: "memory");
}
DEVI void p0_prologue(const P& p, unsigned char* lds) {
    const int tid = opaque_tid(), wave = tid >> 6, lane = tid & 63;
    LAS float* scr = (LAS float*)((LAS unsigned char*)lds + wave * 16384);
    const int gw = blockIdx.x * NWAVES + wave, NGW = gridDim.x * NWAVES;
    bf16_t* win_t = (bf16_t*)(p.ws + WS_WIN); bf16_t* wout_t = (bf16_t*)(p.ws + WS_WOUT);
    constexpr int I_IN = (D / 64) * (INW / 32), I_OUT = (MIXW / 64) * (D / 32);
    constexpr int I_E = NE * (D / 64) * (FF / 32);
    bf16_t* wgu_t = (bf16_t*)(p.ws + WS_WGU); bf16_t* wd_t = (bf16_t*)(p.ws + WS_WD);
    for (int it = gw; it < 3 * I_E; it += NGW) {
        const int fam = it / I_E, r = it % I_E, e = r >> 10, q = r & 1023;
        if (fam < 2) { const int kb = q >> 5, nb = q & 31, n0 = nb * 32;
            transpose_item(p.in[fam == 0 ? I_WGATE : I_WUP] + (size_t)e * D * FF, FF, kb * 64, n0, wgu_t + ((size_t)e * 2048 + (n0 >> 7) * 256 + fam * 128 + (n0 & 127)) * D + kb * 64, D, scr, lane); }
        else { const int kb = q >> 6, nb = q & 63, n0 = nb * 32;
            transpose_item(p.in[I_WDOWN] + (size_t)e * FF * D, D, kb * 64, n0, wd_t + ((size_t)e * 2048 + n0) * FF + kb * 64, FF, scr, lane); }
    }
    for (int it = gw; it < 160; it += NGW) {
        const int mat = it >> 3, q = it & 7, kb = q >> 2, nb = q & 3;
        const float* src = mat < 4 ? p.in[I_WPOOL] + (size_t)mat * 16384 : (mat < 12 ? p.in[I_WA] + (size_t)(mat - 4) * 16384 : p.in[I_WX] + (size_t)(mat - 12) * 16384);
        bf16_t* dstm = mat < 4 ? (bf16_t*)(p.ws + WS_WPT) + (size_t)mat * 16384 : (mat < 12 ? (bf16_t*)(p.ws + WS_WAT) + (size_t)(mat - 4) * 16384 : (bf16_t*)(p.ws + WS_WXT) + (size_t)(mat - 12) * 16384);
        transpose_item(src, 128, kb * 64, nb * 32, dstm + (size_t)(nb * 32) * 128 + kb * 64, 128, scr, lane);
    }
    for (int it = gw; it < I_IN + I_OUT; it += NGW) {
        if (it < I_IN) { const int kb = it / (INW / 32), nb = it % (INW / 32); transpose_item(p.in[I_WIN], INW, kb * 64, nb * 32, win_t + (size_t)(nb * 32) * D + kb * 64, D, scr, lane); }
        else { const int r = it - I_IN, kb = r / (D / 32), nb = r % (D / 32); transpose_item(p.in[I_WOUT], D, kb * 64, nb * 32, wout_t + (size_t)(nb * 32) * MIXW + kb * 64, MIXW, scr, lane); }
    }
    const float* x = p.in[I_X]; bf16_t* xb = (bf16_t*)(p.ws + WS_XB);
    const size_t n8 = (size_t)M * D / 8;
    for (size_t i = (size_t)blockIdx.x * NT + tid; i < n8; i += (size_t)gridDim.x * NT) {
        const f32x4 a = *(const f32x4*)(x + i * 8), b = *(const f32x4*)(x + i * 8 + 4);
        v4u o; o.x = pk2(a[0], a[1]); o.y = pk2(a[2], a[3]); o.z = pk2(b[0], b[1]); o.w = pk2(b[2], b[3]);
        *(v4u*)(xb + i * 8) = o;
    }
}
DEVI void p1_inproj(const P& p, unsigned char* lds) {
    pg8::Gemm g{(const bf16_t*)(p.ws + WS_XB), (const bf16_t*)(p.ws + WS_WIN), M, INW, D}; pg8::StaticOrder S; S.init(M, INW, (int)gridDim.x, (int)blockIdx.x);
    pg8::EpiBf16<0> E{(bf16_t*)(p.ws + WS_HB), INW, nullptr, 0, 0, 1.f};
    pg8::gemm_phase<pg8::EpiBf16<0>, pg8::StaticOrder, true, true>((PG8_LAS unsigned char*)lds, g, S, E);
}
DEVI void p3_outproj(const P& p, unsigned char* lds) {
    pg8::Gemm g{(const bf16_t*)(p.ws + WS_MIX), (const bf16_t*)(p.ws + WS_WOUT), M, D, MIXW}; pg8::StaticOrder S; S.init(M, D, (int)gridDim.x, (int)blockIdx.x);
    EpiZ E{p.in[I_X], p.out, D};
    pg8::gemm_phase<EpiZ, pg8::StaticOrder, true, true>((PG8_LAS unsigned char*)lds, g, S, E);
}


constexpr int MOE_TAB_OFF = 131072;
struct MoeOrder {
    const LAS int* tab; int T, G, c;
    __device__ __forceinline__ bool next(int i, pg8::Unit& u) const {
        int mt, nt;
        if ((G & 63) == 0) { const int cpx = G >> 3, mpx = cpx >> 3, x = c & 7, j = c >> 3; mt = i * (G >> 3) + x * mpx + (j >> 3); nt = j & 7; }
        else { const int L = i * G + c; mt = L >> 3; nt = L & 7; }
        if (mt >= T) return false;
        u.pm = mt; u.pn = __builtin_amdgcn_readfirstlane(tab[64 + mt]) * 8 + nt; return true;
    }
    __device__ __forceinline__ void a_ready(const pg8::Unit&) const {}
    __device__ __forceinline__ void done(const pg8::Unit&) const {}
};
DEVI void moe_tables(const P& p, unsigned char* lds) {
    LAS int* tab = (LAS int*)((LAS unsigned char*)lds + MOE_TAB_OFF);
    const int* cnt = (const int*)(p.ws + WS_CTL) + CW_CNT;
    if (threadIdx.x == 0) { int o = 0, t = 0;
        for (int e = 0; e < NE; ++e) { tab[e] = o; const int nt = (cnt[e] + 255) >> 8; for (int q = 0; q < nt; ++q) tab[64 + t + q] = e; t += nt; o += nt * 256; }
        tab[NE] = o; tab[33] = t; }
    __syncthreads();
}
struct EpiGU {
    static constexpr bool PERM = true, AFTER_DRAIN = false;
    bf16_t* O;
    __device__ __forceinline__ void operator()(const pg8::f32x4 (&acc)[2][2][4][2], const pg8::Unit& u, int wr, int wc, int fr, int fq) const {
        const int row0 = u.pm * pg8::BM + wr * 64 + fr, col0 = (u.pn & 7) * 128 + wc * 32 + 8 * fq;
#pragma unroll
        for (int ai = 0; ai < 2; ++ai)
#pragma unroll
            for (int m = 0; m < 4; ++m) { bf16_t* rowp = O + (size_t)(row0 + ai * pg8::HALF + m * 16) * FF + col0;
                float h[8];
#pragma unroll
                for (int n = 0; n < 2; ++n)
#pragma unroll
                    for (int e = 0; e < 4; ++e) { const float g = acc[ai][0][m][n][e], up = acc[ai][1][m][n][e]; h[4 * n + e] = g * __builtin_amdgcn_rcpf(1.f + __expf(-g)) * up; }
                pg8::u32x4 w; w.x = pg8::cvt_pk_bf16(h[0], h[1]); w.y = pg8::cvt_pk_bf16(h[2], h[3]); w.z = pg8::cvt_pk_bf16(h[4], h[5]); w.w = pg8::cvt_pk_bf16(h[6], h[7]);
                *(pg8::u32x4*)rowp = w; }
    }
};
DEVI void p5_expert1(const P& p, unsigned char* lds) {
    moe_tables(p, lds);
    const LAS int* tab = (const LAS int*)((LAS unsigned char*)lds + MOE_TAB_OFF);
    MoeOrder S{tab, __builtin_amdgcn_readfirstlane(tab[33]), (int)gridDim.x, (int)blockIdx.x};
    pg8::Gemm g{(const bf16_t*)(p.ws + WS_XG), (const bf16_t*)(p.ws + WS_WGU), 0, 0, D};
    EpiGU E{(bf16_t*)(p.ws + WS_HD)};
    pg8::gemm_phase<EpiGU, MoeOrder, true, true>((PG8_LAS unsigned char*)lds, g, S, E);
}
DEVI void p6_expert2(const P& p, unsigned char* lds) {
    moe_tables(p, lds);
    const LAS int* tab = (const LAS int*)((LAS unsigned char*)lds + MOE_TAB_OFF);
    MoeOrder S{tab, __builtin_amdgcn_readfirstlane(tab[33]), (int)gridDim.x, (int)blockIdx.x};
    pg8::Gemm g{(const bf16_t*)(p.ws + WS_HD), (const bf16_t*)(p.ws + WS_WD), 0, 0, FF};
    pg8::EpiBf16<0> E{(bf16_t*)(p.ws + WS_YB), D, nullptr, 2048, 0, 1.f};
    pg8::gemm_phase<pg8::EpiBf16<0>, MoeOrder, true, true>((PG8_LAS unsigned char*)lds, g, S, E);
}


typedef short bf16x8 __attribute__((ext_vector_type(8)));
typedef float f32x16 __attribute__((ext_vector_type(16)));
typedef float f32x2_t __attribute__((ext_vector_type(2))); typedef __bf16 bf16x2_t __attribute__((ext_vector_type(2)));
DEVI unsigned cvtpk(float lo, float hi) { f32x2_t v = {lo, hi}; bf16x2_t b = __builtin_convertvector(v, bf16x2_t); return __builtin_bit_cast(unsigned, b); }
DEVI bf16x8 pack8(float a0, float a1, float a2, float a3, float a4, float a5, float a6, float a7) {
    v4u o; o.x = cvtpk(a0, a1); o.y = cvtpk(a2, a3); o.z = cvtpk(a4, a5); o.w = cvtpk(a6, a7); return __builtin_bit_cast(bf16x8, o); }
DEVI f32x16 zero16() { f32x16 z;
#pragma unroll
    for (int i = 0; i < 16; ++i) z[i] = 0.f; return z; }
#define MFMA32(a, b, c) __builtin_amdgcn_mfma_f32_32x32x16_bf16((a), (b), (c), 0, 0, 0)
DEVI float xhalf(float v) { return __shfl_xor(v, 32); }

DEVI void p0_kv(const P& p, unsigned char* lds) {
    const int tid = opaque_tid(), wave = tid >> 6, lane = tid & 63, r32 = lane & 31, hh = lane >> 5;
    const float* mem = p.in[I_MEM]; const float* wkv = p.in[I_WKV]; bf16_t* kb = (bf16_t*)(p.ws + WS_KB); bf16_t* vt = (bf16_t*)(p.ws + WS_VT);
    LAS float* red = (LAS float*)(LAS unsigned char*)lds;
    for (int blk = blockIdx.x; blk < 256; blk += gridDim.x) {
        const int rb = blk >> 4, cb = blk & 15, row0 = rb * 32, n0 = cb * 64;
        f32x16 acc0 = zero16(), acc1 = zero16();
        const float* arow = mem + (size_t)(row0 + r32) * D + wave * 256 + 8 * hh;
        const float* bcol = wkv + (size_t)(wave * 256 + 8 * hh) * (2 * MEMW) + n0 + r32;
#pragma unroll 2
        for (int ks = 0; ks < 16; ++ks) {
            const f32x4 a0 = *(const f32x4*)(arow + ks * 16), a1 = *(const f32x4*)(arow + ks * 16 + 4);
            float b0[8], b1[8];
#pragma unroll
            for (int j = 0; j < 8; ++j) { b0[j] = bcol[(size_t)(ks * 16 + j) * (2 * MEMW)]; b1[j] = bcol[(size_t)(ks * 16 + j) * (2 * MEMW) + 32]; }
            const bf16x8 af = pack8(a0[0], a0[1], a0[2], a0[3], a1[0], a1[1], a1[2], a1[3]);
            acc0 = MFMA32(af, pack8(b0[0], b0[1], b0[2], b0[3], b0[4], b0[5], b0[6], b0[7]), acc0);
            acc1 = MFMA32(af, pack8(b1[0], b1[1], b1[2], b1[3], b1[4], b1[5], b1[6], b1[7]), acc1);
        }
#pragma unroll
        for (int r = 0; r < 16; ++r) { red[(wave * 32 + r) * 64 + lane] = acc0[r]; red[(wave * 32 + 16 + r) * 64 + lane] = acc1[r]; }
        __syncthreads();
#pragma unroll
        for (int i = 0; i < 4; ++i) { const int e = tid + i * NT; float v = 0.f;
#pragma unroll
            for (int w = 0; w < 8; ++w) v += red[w * 2048 + e];
            const int tl = e >> 10, reg = (e >> 6) & 15, ln = e & 63;
            const int R = row0 + (reg & 3) + 8 * (reg >> 2) + 4 * (ln >> 5), n = n0 + 32 * tl + (ln & 31), b = R >> 8, key = R & 255;
            if (n < MEMW) { const int hd = n >> 7, d = n & 127; kb[((size_t)(b * 4 + hd) * MEMLEN + key) * 128 + d] = f2bf(v); }
            else { const int n2 = n - MEMW, hd = n2 >> 7, d = n2 & 127; vt[((size_t)(b * 4 + hd) * 128 + d) * MEMLEN + permkey(key)] = f2bf(v); } }
        __syncthreads();
    }
}

DEVI void p2_attn(const P& p, unsigned char* lds, int tile) {
    const int tid = opaque_tid(), wave = __builtin_amdgcn_readfirstlane(tid >> 6), lane = tid & 63, r32 = lane & 31, hh = lane >> 5;
    const int hd = wave >> 1, mt = wave & 1, t0 = tile * 64 + mt * 32, b = t0 / SEQ;
    const bf16_t* hb = (const bf16_t*)(p.ws + WS_HB); const bf16_t* kb = (const bf16_t*)(p.ws + WS_KB); const bf16_t* vt = (const bf16_t*)(p.ws + WS_VT); bf16_t* mix = (bf16_t*)(p.ws + WS_MIX);
    bf16x8 qf[8];
    const bf16_t* qrow = hb + (size_t)(t0 + r32) * INW + (POOLW + 2 * LRUW) + hd * 128 + hh * 8;
#pragma unroll
    for (int ks = 0; ks < 8; ++ks) qf[ks] = *(const bf16x8*)(qrow + ks * 16);
    f32x16 s[8];
    const bf16_t* kbase = kb + ((size_t)(b * 4 + hd) * MEMLEN + r32) * 128 + hh * 8;
#pragma unroll
    for (int kt = 0; kt < 8; ++kt) { s[kt] = zero16();
#pragma unroll
        for (int ks = 0; ks < 8; ++ks) { const bf16x8 kf = *(const bf16x8*)(kbase + (size_t)kt * 32 * 128 + ks * 16); s[kt] = MFMA32(kf, qf[ks], s[kt]); }
        asm volatile("" ::: "memory"); }
    float mx = -3.0e38f;
#pragma unroll
    for (int kt = 0; kt < 8; ++kt)
#pragma unroll
        for (int r = 0; r < 16; ++r) mx = fmaxf(mx, s[kt][r]);
    mx = fmaxf(mx, xhalf(mx));
    const float sc = 0.08838834764831845f * 1.4426950408889634f; float sum = 0.f;
#pragma unroll
    for (int kt = 0; kt < 8; ++kt)
#pragma unroll
        for (int r = 0; r < 16; ++r) { const float pv = __builtin_amdgcn_exp2f((s[kt][r] - mx) * sc); s[kt][r] = pv; sum += pv; }
    sum += xhalf(sum);
    const float inv = 1.f / sum;
    f32x16 o[4];
#pragma unroll
    for (int dt = 0; dt < 4; ++dt) o[dt] = zero16();
    const bf16_t* vbase = vt + ((size_t)(b * 4 + hd) * 128 + r32) * MEMLEN + hh * 8;
#pragma unroll
    for (int kt = 0; kt < 8; ++kt)
#pragma unroll
        for (int si = 0; si < 2; ++si) {
            const bf16x8 pf = pack8(s[kt][8 * si], s[kt][8 * si + 1], s[kt][8 * si + 2], s[kt][8 * si + 3], s[kt][8 * si + 4], s[kt][8 * si + 5], s[kt][8 * si + 6], s[kt][8 * si + 7]);
#pragma unroll
            for (int dt = 0; dt < 4; ++dt) { const bf16x8 vf = *(const bf16x8*)(vbase + (size_t)dt * 32 * MEMLEN + kt * 32 + si * 16); o[dt] = MFMA32(vf, pf, o[dt]); }
            asm volatile("" ::: "memory"); }
    float ss = 0.f;
#pragma unroll
    for (int dt = 0; dt < 4; ++dt)
#pragma unroll
        for (int r = 0; r < 16; ++r) { o[dt][r] *= inv; ss = fmaf(o[dt][r], o[dt][r], ss); }
    ss += xhalf(ss);
    LAS float* ssm = (LAS float*)(LAS unsigned char*)lds;
    if (hh == 0) ssm[wave * 32 + r32] = ss;
    __syncthreads();
    const float tot = (ssm[mt * 32 + r32] + ssm[(2 + mt) * 32 + r32]) + (ssm[(4 + mt) * 32 + r32] + ssm[(6 + mt) * 32 + r32]);
    const float rs = rsqrtf(tot * (1.f / MEMW) + EPS);
    const float* gain = p.in[I_MIXG] + POOLW + LRUW + hd * 128;
    bf16_t* mrow = mix + (size_t)(t0 + r32) * MIXW + POOLW + LRUW + hd * 128;
#pragma unroll
    for (int dt = 0; dt < 4; ++dt)
#pragma unroll
        for (int rg = 0; rg < 4; ++rg) { const int c = 32 * dt + 8 * rg + 4 * hh; const f32x4 g = *(const f32x4*)(gain + c);
            uint2 w; w.x = cvtpk(o[dt][4 * rg] * rs * g[0], o[dt][4 * rg + 1] * rs * g[1]); w.y = cvtpk(o[dt][4 * rg + 2] * rs * g[2], o[dt][4 * rg + 3] * rs * g[3]);
            *(uint2*)(mrow + c) = w; }
    __syncthreads();
}


DEVI float bflo(unsigned w) { return __uint_as_float(w << 16); }
DEVI float bfhi(unsigned w) { return __uint_as_float(w & 0xffff0000u); }
DEVI void p2_pool(const P& p, unsigned char* lds, int tile) {
    const int tid = opaque_tid(), wave = __builtin_amdgcn_readfirstlane(tid >> 6), lane = tid & 63, r32 = lane & 31, hh = lane >> 5;
    const int g = wave >> 1, mt = wave & 1, W = 2 << g, t = tile * 64 + mt * 32 + r32, pos = t % SEQ;
    const bf16_t* hb = (const bf16_t*)(p.ws + WS_HB); const bf16_t* wpt = (const bf16_t*)(p.ws + WS_WPT) + (size_t)g * 16384; bf16_t* mix = (bf16_t*)(p.ws + WS_MIX);
    const float invc = 1.f / (float)((pos + 1 < W) ? pos + 1 : W);
    f32x16 acc[4];
#pragma unroll
    for (int nt = 0; nt < 4; ++nt) acc[nt] = zero16();
    const bf16_t* urow = hb + (size_t)t * INW + g * 128 + hh * 8;
#pragma unroll 2
    for (int ks = 0; ks < 8; ++ks) {
        float sm8[8];
#pragma unroll
        for (int j = 0; j < 8; ++j) sm8[j] = 0.f;
        float cur[8];
        for (int tau = 0; tau < W; ++tau) {
            v4u raw = {0u, 0u, 0u, 0u};
            if (pos - tau >= 0) raw = *(const v4u*)(urow - (size_t)tau * INW + ks * 16);
            const float x0 = bflo(raw.x), x1 = bfhi(raw.x), x2 = bflo(raw.y), x3 = bfhi(raw.y), x4 = bflo(raw.z), x5 = bfhi(raw.z), x6 = bflo(raw.w), x7 = bfhi(raw.w);
            if (tau == 0) { cur[0] = x0; cur[1] = x1; cur[2] = x2; cur[3] = x3; cur[4] = x4; cur[5] = x5; cur[6] = x6; cur[7] = x7; }
            sm8[0] += x0; sm8[1] += x1; sm8[2] += x2; sm8[3] += x3; sm8[4] += x4; sm8[5] += x5; sm8[6] += x6; sm8[7] += x7;
        }
        const bf16x8 df = pack8(sm8[0] * invc - cur[0], sm8[1] * invc - cur[1], sm8[2] * invc - cur[2], sm8[3] * invc - cur[3],
                                sm8[4] * invc - cur[4], sm8[5] * invc - cur[5], sm8[6] * invc - cur[6], sm8[7] * invc - cur[7]);
#pragma unroll
        for (int nt = 0; nt < 4; ++nt) { const bf16x8 wf = *(const bf16x8*)(wpt + (size_t)(nt * 32 + r32) * 128 + ks * 16 + hh * 8); acc[nt] = MFMA32(wf, df, acc[nt]); }
    }
    const float* psc = p.in[I_PSCALE] + g * 128; float ss = 0.f;
#pragma unroll
    for (int nt = 0; nt < 4; ++nt)
#pragma unroll
        for (int rg = 0; rg < 4; ++rg) { const f32x4 s4 = *(const f32x4*)(psc + nt * 32 + 8 * rg + 4 * hh);
#pragma unroll
            for (int e = 0; e < 4; ++e) { const float y = acc[nt][4 * rg + e] * s4[e]; acc[nt][4 * rg + e] = y; ss = fmaf(y, y, ss); } }
    ss += xhalf(ss);
    LAS float* ssm = (LAS float*)(LAS unsigned char*)lds;
    if (hh == 0) ssm[wave * 32 + r32] = ss;
    __syncthreads();
    const float tot = (ssm[mt * 32 + r32] + ssm[(2 + mt) * 32 + r32]) + (ssm[(4 + mt) * 32 + r32] + ssm[(6 + mt) * 32 + r32]);
    const float rs = rsqrtf(tot * (1.f / POOLW) + EPS);
    const float* gain = p.in[I_MIXG] + g * 128;
    bf16_t* mrow = mix + (size_t)t * MIXW + g * 128;
#pragma unroll
    for (int nt = 0; nt < 4; ++nt)
#pragma unroll
        for (int rg = 0; rg < 4; ++rg) { const int c = 32 * nt + 8 * rg + 4 * hh; const f32x4 gv = *(const f32x4*)(gain + c);
            uint2 w; w.x = cvtpk(acc[nt][4 * rg] * rs * gv[0], acc[nt][4 * rg + 1] * rs * gv[1]); w.y = cvtpk(acc[nt][4 * rg + 2] * rs * gv[2], acc[nt][4 * rg + 3] * rs * gv[3]);
            *(uint2*)(mrow + c) = w; }
    __syncthreads();
}

DEVI float fast_sigmoid(float v) { return __builtin_amdgcn_rcpf(1.f + __expf(-v)); }
DEVI float one_minus_exp(float x) {
    const float ser = -x * (1.f + x * (0.5f + x * (0.16666667f + x * (0.041666668f + x * 0.0083333338f))));
    const float dir = 1.f - __expf(x);
    return (x > -0.125f) ? ser : dir;
}
typedef __amdgpu_buffer_rsrc_t rsrc_t;
typedef unsigned v2u __attribute__((ext_vector_type(2)));
DEVI rsrc_t mkrsrc(const void* ptr, unsigned bytes) { return __builtin_amdgcn_make_buffer_rsrc((void*)ptr, 0, (int)bytes, 0x00020000); }
DEVI v4u bl128(rsrc_t r, unsigned vo, unsigned so) { return __builtin_amdgcn_raw_buffer_load_b128(r, (int)vo, (int)so, 0); }
DEVI v2u bl64(rsrc_t r, unsigned vo, unsigned so) { return __builtin_amdgcn_raw_buffer_load_b64(r, (int)vo, (int)so, 0); }
DEVI unsigned bl32(rsrc_t r, unsigned vo, unsigned so) { return __builtin_amdgcn_raw_buffer_load_b32(r, (int)vo, (int)so, 0); }
DEVI f32x4 bl128f(rsrc_t r, unsigned vo, unsigned so) { return __builtin_bit_cast(f32x4, bl128(r, vo, so)); }
DEVI float bl32f(rsrc_t r, unsigned vo, unsigned so) { return __uint_as_float(bl32(r, vo, so)); }
DEVI void bs32(rsrc_t r, unsigned vo, unsigned so, unsigned v) { __builtin_amdgcn_raw_buffer_store_b32(v, r, (int)vo, (int)so, 0); }
DEVI void bs64(rsrc_t r, unsigned vo, unsigned so, v2u v) { __builtin_amdgcn_raw_buffer_store_b64(v, r, (int)vo, (int)so, 0); }

DEVI void p2_lru_local(const P& p, int tile) {
    const int tid = opaque_tid(), h = __builtin_amdgcn_readfirstlane(tid >> 6), lane = tid & 63, r32 = lane & 31, hh = lane >> 5;
    const int t0 = tile * 64, pos0 = t0 % SEQ;
    const rsrc_t Rhb = mkrsrc(p.ws + WS_HB, (unsigned)((size_t)M * INW * 2)), Rwa = mkrsrc(p.ws + WS_WAT, 8 * 16384 * 2), Rwx = mkrsrc(p.ws + WS_WXT, 8 * 16384 * 2);
    const rsrc_t Rhc = mkrsrc(p.ws + WS_HC, (unsigned)((size_t)M * LRUW * 4)), Ragg = mkrsrc(p.ws + WS_AGG, 256 * LRUW * 8);
    const rsrc_t Rcw = mkrsrc(p.in[I_CONVW], 4 * LRUW * 4), Rcb = mkrsrc(p.in[I_CONVB], LRUW * 4), Rba = mkrsrc(p.in[I_BA], LRUW * 4), Rbx = mkrsrc(p.in[I_BX], LRUW * 4), Rlam = mkrsrc(p.in[I_LAM], LRUW * 4);
    const unsigned vo8 = (unsigned)hh * 32u;
    const unsigned voB = (unsigned)(r32 * 128 + hh * 8) * 2u;
    const unsigned sch = (unsigned)h * 128u;
    float hcar[4], Acar[4];
#pragma unroll
    for (int nt = 0; nt < 4; ++nt) { hcar[nt] = 0.f; Acar[nt] = 1.f; }
#pragma unroll 1
    for (int mt = 0; mt < 2; ++mt) {
        const int t = t0 + mt * 32 + r32, pos = pos0 + mt * 32 + r32;
        unsigned rofs[4]; float rm[4];
#pragma unroll
        for (int tau = 0; tau < 4; ++tau) { const bool ok = (pos - 3 + tau) >= 0;
            rofs[tau] = (unsigned)((ok ? t - 3 + tau : t) * INW + hh * 8) * 2u; rm[tau] = ok ? 1.f : 0.f; }
        bf16x8 af[8];
#pragma unroll
        for (int ks = 0; ks < 8; ++ks) {
            f32x4 ua = bl128f(Rcb, vo8 + ks * 64, sch * 4u), ub = bl128f(Rcb, vo8 + ks * 64 + 16, sch * 4u);
#pragma unroll
            for (int tau = 0; tau < 4; ++tau) {
                const v4u raw = bl128(Rhb, rofs[tau] + ks * 32, (POOLW + sch) * 2u);
                const f32x4 w0 = bl128f(Rcw, vo8 + ks * 64, (tau * LRUW + sch) * 4u), w1 = bl128f(Rcw, vo8 + ks * 64 + 16, (tau * LRUW + sch) * 4u);
                f32x4 xa = {bflo(raw.x), bfhi(raw.x), bflo(raw.y), bfhi(raw.y)}, xb = {bflo(raw.z), bfhi(raw.z), bflo(raw.w), bfhi(raw.w)};
                ua += (w0 * rm[tau]) * xa; ub += (w1 * rm[tau]) * xb;
            }
            af[ks] = pack8(ua[0], ua[1], ua[2], ua[3], ub[0], ub[1], ub[2], ub[3]);
            if (ks & 1) { asm volatile("" ::: "memory"); __builtin_amdgcn_sched_barrier(0); }
        }
#pragma unroll
        for (int nt = 0; nt < 4; ++nt) {
            asm volatile("" ::: "memory"); __builtin_amdgcn_sched_barrier(0);
            f32x16 ra = zero16(), rx = zero16(), uc = zero16();
            const unsigned sw = (unsigned)(h * 16384 + nt * 4096) * 2u;
#pragma unroll
            for (int ks = 0; ks < 8; ++ks) {
                const bf16x8 wa = __builtin_bit_cast(bf16x8, bl128(Rwa, voB + ks * 32, sw)), wx = __builtin_bit_cast(bf16x8, bl128(Rwx, voB + ks * 32, sw));
                ra = MFMA32(af[ks], wa, ra); rx = MFMA32(af[ks], wx, rx);
            }
#pragma unroll
            for (int q = 0; q < 2; ++q) {
                const int jj = r32 - 16 * q - 8 * hh;
                v4u idw;
                idw.x = (jj == 0) ? 0x00003F80u : ((jj == 1) ? 0x3F800000u : 0u); idw.y = (jj == 2) ? 0x00003F80u : ((jj == 3) ? 0x3F800000u : 0u);
                idw.z = (jj == 4) ? 0x00003F80u : ((jj == 5) ? 0x3F800000u : 0u); idw.w = (jj == 6) ? 0x00003F80u : ((jj == 7) ? 0x3F800000u : 0u);
                uc = MFMA32(af[2 * nt + q], __builtin_bit_cast(bf16x8, idw), uc);
            }
            const unsigned vc = (unsigned)r32 * 4u, sc4 = (sch + nt * 32) * 4u;
            const float bac = bl32f(Rba, vc, sc4), bxc = bl32f(Rbx, vc, sc4), sp8 = -8.f * log1pf(__expf(-bl32f(Rlam, vc, sc4)));
#pragma unroll
            for (int r = 0; r < 16; ++r) {
                const float rr = fast_sigmoid(ra[r] + bac), ii = fast_sigmoid(rx[r] + bxc);
                const float la = rr * sp8, a = __expf(la), mult = __builtin_amdgcn_sqrtf(fmaxf(one_minus_exp(2.f * la), 0.f));
                ra[r] = a; rx[r] = mult * ii * uc[r];
            }
            float hc = hcar[nt], Ac = Acar[nt];
#pragma unroll
            for (int g4 = 0; g4 < 4; ++g4) {
                const int rb = g4 * 4;
                const float a0 = ra[rb], a1 = ra[rb + 1], a2 = ra[rb + 2], a3 = ra[rb + 3];
                const float b0 = rx[rb], b1 = rx[rb + 1], b2 = rx[rb + 2], b3 = rx[rb + 3];
                const float P0 = a0, l0 = b0, P1 = a1 * P0, l1 = fmaf(a1, l0, b1), P2 = a2 * P1, l2 = fmaf(a2, l1, b2), P3 = a3 * P2, l3 = fmaf(a3, l2, b3);
                const float he = fmaf(P3, hc, l3), Ae = P3 * Ac;
                float th = xhalf(he), tA = xhalf(Ae);
                if (hh) { hc = th; Ac = tA; }
                const float h0 = fmaf(P0, hc, l0), h1 = fmaf(P1, hc, l1), h2 = fmaf(P2, hc, l2), h3 = fmaf(P3, hc, l3);
                const float c0 = P0 * Ac, c1 = P1 * Ac, c2 = P2 * Ac, c3 = P3 * Ac;
                rx[rb] = h0; rx[rb + 1] = h1; rx[rb + 2] = h2; rx[rb + 3] = h3;
                ra[rb] = c0; ra[rb + 1] = c1; ra[rb + 2] = c2; ra[rb + 3] = c3;
                th = xhalf(h3); tA = xhalf(c3);
                if (!hh) { hc = th; Ac = tA; }
            }
            hcar[nt] = hc; Acar[nt] = Ac;
            const unsigned vhc = (unsigned)(4 * hh * LRUW + r32) * 4u;
#pragma unroll
            for (int r = 0; r < 16; ++r) bs32(Rhc, vhc, (unsigned)((t0 + mt * 32 + (r & 3) + 8 * (r >> 2)) * LRUW + sch + nt * 32) * 4u, cvtpk(rx[r], ra[r]));
            if (mt == 1 && !hh) { v2u ag = {__float_as_uint(Ac), __float_as_uint(hc)}; bs64(Ragg, (unsigned)r32 * 8u, (unsigned)(tile * LRUW + sch + nt * 32) * 8u, ag); }
        }
    }
}
DEVI void p2_lru_final(const P& p, unsigned char* lds, int tile) {
    const int tid = opaque_tid(), h = __builtin_amdgcn_readfirstlane(tid >> 6), lane = tid & 63;
    const int c = h * 128 + 2 * lane, t0 = tile * 64, j0 = (tile / (SEQ / 64)) * (SEQ / 64);
    const bf16_t* hb = (const bf16_t*)(p.ws + WS_HB); const unsigned* HC = (const unsigned*)(p.ws + WS_HC); const float* agg = (const float*)(p.ws + WS_AGG); bf16_t* mix = (bf16_t*)(p.ws + WS_MIX);
    float h0 = 0.f, h1 = 0.f;
#pragma unroll 8
    for (int j = j0; j < tile; ++j) { const f32x4 ag = *(const f32x4*)(agg + ((size_t)j * LRUW + c) * 2); h0 = fmaf(ag[0], h0, ag[1]); h1 = fmaf(ag[2], h1, ag[3]); }
    float sq[64];
#define LRU_Y(tt) \
        const uint2 hc2 = *(const uint2*)(HC + (size_t)(t0 + (tt)) * LRUW + c); const unsigned gt = *(const unsigned*)(hb + (size_t)(t0 + (tt)) * INW + POOLW + LRUW + c); \
        const float g0 = bflo(gt), g1 = bfhi(gt); \
        const float u0 = 0.7978845608028654f * (g0 + 0.044715f * g0 * g0 * g0), u1 = 0.7978845608028654f * (g1 + 0.044715f * g1 * g1 * g1); \
        const float y0 = g0 / (1.f + __expf(-2.f * u0)) * fmaf(bfhi(hc2.x), h0, bflo(hc2.x)), y1 = g1 / (1.f + __expf(-2.f * u1)) * fmaf(bfhi(hc2.y), h1, bflo(hc2.y));
#pragma unroll
    for (int tt = 0; tt < 64; ++tt) { LRU_Y(tt) sq[tt] = fmaf(y0, y0, y1 * y1); if ((tt & 7) == 7) asm volatile("" ::: "memory"); }
#pragma unroll
    for (int o = 32; o >= 1; o >>= 1) {
        const bool up = (lane & o) != 0;
#pragma unroll
        for (int i = 0; i < o; ++i) { const float send = up ? sq[i] : sq[i + o], keep = up ? sq[i + o] : sq[i]; sq[i] = keep + __shfl_xor(send, o); }
    }
    LAS float* ssm = (LAS float*)(LAS unsigned char*)lds;
    ssm[h * 64 + lane] = sq[0];
    __syncthreads();
    float tot = 0.f;
#pragma unroll
    for (int w = 0; w < 8; ++w) tot += ssm[w * 64 + lane];
    ssm[512 + h * 64 + lane] = rsqrtf(tot * (1.f / LRUW) + EPS);
    __syncthreads();
    const float gn0 = p.in[I_MIXG][POOLW + c], gn1 = p.in[I_MIXG][POOLW + c + 1];
#pragma unroll 8
    for (int tt = 0; tt < 64; ++tt) { const float rs = ssm[512 + h * 64 + tt]; LRU_Y(tt)
        *(unsigned*)(mix + (size_t)(t0 + tt) * MIXW + POOLW + c) = cvtpk(y0 * rs * gn0, y1 * rs * gn1); }
#undef LRU_Y
    __syncthreads();
}

template <bool DUAL, class AL, class BL, class BL2, class EP>
DEVI void sgemm_tile(int m0, int n0, int K, AL aload, BL bload, BL2 bload2, EP epi, float* sm) {
    float* As = sm;
    float* Bs = sm + 16 * 132;
    float* Bs2 = Bs + 16 * 68;
    const int tid = opaque_tid(), ty = tid >> 4, tx = tid & 15;
    float acc[4][4], acc2[4][4];
#pragma unroll
    for (int i = 0; i < 4; ++i)
#pragma unroll
        for (int j = 0; j < 4; ++j) { acc[i][j] = 0.f; acc2[i][j] = 0.f; }
    for (int k0 = 0; k0 < K; k0 += 16) {
#pragma unroll
        for (int i = 0; i < 4; ++i) { const int e = tid + i * NT, r = e >> 4, kk = e & 15; As[kk * 132 + r] = aload(m0 + r, k0 + kk); }
#pragma unroll
        for (int i = 0; i < 2; ++i) { const int e = tid + i * NT, kk = e >> 6, n = e & 63; Bs[kk * 68 + n] = bload(k0 + kk, n0 + n); if (DUAL) Bs2[kk * 68 + n] = bload2(k0 + kk, n0 + n); }
        __syncthreads();
#pragma unroll
        for (int kk = 0; kk < 16; ++kk) {
            const float4 a = *(const float4*)(As + kk * 132 + ty * 4);
            const float4 b = *(const float4*)(Bs + kk * 68 + tx * 4);
            const float av[4] = {a.x, a.y, a.z, a.w}, bv[4] = {b.x, b.y, b.z, b.w};
#pragma unroll
            for (int i = 0; i < 4; ++i)
#pragma unroll
                for (int j = 0; j < 4; ++j) acc[i][j] = fmaf(av[i], bv[j], acc[i][j]);
            if (DUAL) {
                const float4 b2 = *(const float4*)(Bs2 + kk * 68 + tx * 4);
                const float bw[4] = {b2.x, b2.y, b2.z, b2.w};
#pragma unroll
                for (int i = 0; i < 4; ++i)
#pragma unroll
                    for (int j = 0; j < 4; ++j) acc2[i][j] = fmaf(av[i], bw[j], acc2[i][j]);
            }
        }
        __syncthreads();
    }
#pragma unroll
    for (int i = 0; i < 4; ++i)
#pragma unroll
        for (int j = 0; j < 4; ++j) epi(m0 + ty * 4 + i, n0 + tx * 4 + j, acc[i][j], acc2[i][j]);
}

DEVI void s1_inproj(const P& p, float* sm) {
    const float* x = p.in[I_X]; const float* w = p.in[I_WIN]; bf16_t* hb = (bf16_t*)(p.ws + WS_HB);
#if NAIVE_INPROJ
    const int ntn = INW / 64, nt = (M / 128) * ntn;
    for (int it = blockIdx.x; it < nt; it += gridDim.x) {
        const int m0 = (it / ntn) * 128, n0 = (it % ntn) * 64;
        auto al = [&](int r, int k) { return x[(size_t)r * D + k]; };
        auto bl = [&](int k, int n) { return w[(size_t)k * INW + n]; };
        auto ep = [&](int r, int n, float v, float) { hb[(size_t)r * INW + n] = f2bf(v); };
        sgemm_tile<false>(m0, n0, D, al, bl, bl, ep, sm);
    }
#else
    (void)x; (void)w; (void)hb;
#endif
    const float* mem = p.in[I_MEM]; const float* wkv = p.in[I_WKV]; bf16_t* kb = (bf16_t*)(p.ws + WS_KB); bf16_t* vt = (bf16_t*)(p.ws + WS_VT);
    const int nt2 = NAIVE_KV ? (BATCH * MEMLEN / 128) * (2 * MEMW / 64) : 0;
    for (int it = blockIdx.x; it < nt2; it += gridDim.x) {
        const int m0 = (it / 16) * 128, n0 = (it % 16) * 64;
        auto al = [&](int r, int k) { return mem[(size_t)r * D + k]; };
        auto bl = [&](int k, int n) { return wkv[(size_t)k * (2 * MEMW) + n]; };
        auto ep = [&](int r, int n, float v, float) {
            const int b = r / MEMLEN, key = r % MEMLEN;
            if (n < MEMW) { const int hd = n >> 7, d = n & 127; kb[((size_t)(b * 4 + hd) * MEMLEN + key) * 128 + d] = f2bf(v); }
            else { const int n2 = n - MEMW, hd = n2 >> 7, d = n2 & 127; vt[((size_t)(b * 4 + hd) * 128 + d) * MEMLEN + permkey(key)] = f2bf(v); }
        };
        sgemm_tile<false>(m0, n0, D, al, bl, bl, ep, sm);
    }
}
DEVI void s2a_pool(const P& p, float* sm) {
    const bf16_t* hb = (const bf16_t*)(p.ws + WS_HB); float* ypool = (float*)(p.ws + WS_YPOOL);
    const float* wp = p.in[I_WPOOL]; const float* ps = p.in[I_PSCALE];
    const int tid = opaque_tid(), g = tid >> 7, c = tid & 127, w = 2 << g;
    for (int t = blockIdx.x; t < M; t += gridDim.x) {
        const int pos = t % SEQ;
        float s = 0.f;
        for (int j = 0; j < w; ++j) if (pos - j >= 0) s += bf2f(hb[(size_t)(t - j) * INW + g * 128 + c]);
        const float cntf = (float)((pos + 1 < w) ? pos + 1 : w);
        sm[tid] = s / cntf - bf2f(hb[(size_t)t * INW + g * 128 + c]);
        __syncthreads();
        float y = 0.f;
        for (int cc = 0; cc < 128; ++cc) y = fmaf(sm[g * 128 + cc], wp[((size_t)g * 128 + cc) * 128 + c], y);
        ypool[(size_t)t * POOLW + g * 128 + c] = y * ps[g * 128 + c];
        __syncthreads();
    }
}
DEVI float sigmoidf_(float v) { return 1.f / (1.f + __expf(-v)); }
DEVI void s2b_lru(const P& p, float* sm) {
    const bf16_t* hb = (const bf16_t*)(p.ws + WS_HB); float* aS = (float*)(p.ws + WS_AS); float* bS = (float*)(p.ws + WS_BS);
    const float* cw = p.in[I_CONVW]; const float* cb = p.in[I_CONVB]; const float* wa = p.in[I_WA]; const float* ba = p.in[I_BA];
    const float* wx = p.in[I_WX]; const float* bx = p.in[I_BX]; const float* lam = p.in[I_LAM];
    const int tid = opaque_tid();
    for (int it = blockIdx.x; it < M / 8; it += gridDim.x) {
        const int t0 = it * 8;
#pragma unroll
        for (int q = 0; q < 2; ++q) { const int c = tid + q * NT;
            for (int tt = 0; tt < 8; ++tt) { const int t = t0 + tt, pos = t % SEQ; float u = cb[c];
#pragma unroll
                for (int j = 0; j < 4; ++j) if (pos - 3 + j >= 0) u = fmaf(cw[j * LRUW + c], bf2f(hb[(size_t)(t - 3 + j) * INW + POOLW + c]), u);
                sm[tt * LRUW + c] = u; } }
        __syncthreads();
#pragma unroll
        for (int q = 0; q < 2; ++q) { const int n = tid + q * NT, h = n >> 7, nn = n & 127;
            float ra[8], rx[8];
#pragma unroll
            for (int tt = 0; tt < 8; ++tt) { ra[tt] = ba[n]; rx[tt] = bx[n]; }
            for (int c = 0; c < 128; ++c) { const float w1 = wa[((size_t)h * 128 + c) * 128 + nn], w2 = wx[((size_t)h * 128 + c) * 128 + nn];
#pragma unroll
                for (int tt = 0; tt < 8; ++tt) { const float u = sm[tt * LRUW + h * 128 + c]; ra[tt] = fmaf(u, w1, ra[tt]); rx[tt] = fmaf(u, w2, rx[tt]); } }
            const float sp = log1pf(expf(-lam[n]));
#pragma unroll
            for (int tt = 0; tt < 8; ++tt) { const float r = sigmoidf_(ra[tt]), ii = sigmoidf_(rx[tt]);
                const float la = -8.f * r * sp, a = expf(la), mult = sqrtf(fmaxf(-expm1f(2.f * la), 0.f));
                aS[(size_t)(t0 + tt) * LRUW + n] = a; bS[(size_t)(t0 + tt) * LRUW + n] = mult * ii * sm[tt * LRUW + n]; } }
        __syncthreads();
    }
}
DEVI float gelu_tanh(float v) { const float u = 0.7978845608028654f * (v + 0.044715f * v * v * v); return 0.5f * v * (1.f + tanhf(u)); }
DEVI void s2c_scan(const P& p, float*) {
    const bf16_t* hb = (const bf16_t*)(p.ws + WS_HB); const float* aS = (const float*)(p.ws + WS_AS); const float* bS = (const float*)(p.ws + WS_BS); float* ylru = (float*)(p.ws + WS_YLRU);
    const int idx = blockIdx.x * NT + threadIdx.x;
    if (idx >= BATCH * LRUW) return;
    const int b = idx / LRUW, c = idx % LRUW; float h = 0.f;
    for (int s0 = 0; s0 < SEQ; s0 += 8) {
        float a[8], bb[8], g[8];
#pragma unroll
        for (int j = 0; j < 8; ++j) { const size_t t = (size_t)b * SEQ + s0 + j; a[j] = aS[t * LRUW + c]; bb[j] = bS[t * LRUW + c]; g[j] = bf2f(hb[t * INW + POOLW + LRUW + c]); }
#pragma unroll
        for (int j = 0; j < 8; ++j) { h = fmaf(a[j], h, bb[j]); ylru[((size_t)b * SEQ + s0 + j) * LRUW + c] = gelu_tanh(g[j]) * h; }
    }
}
DEVI void s2d_attn(const P& p, float* sm) {
    const bf16_t* hb = (const bf16_t*)(p.ws + WS_HB); const bf16_t* kb = (const bf16_t*)(p.ws + WS_KB); const bf16_t* vt = (const bf16_t*)(p.ws + WS_VT); float* ymem = (float*)(p.ws + WS_YMEM);
    const int tid = opaque_tid(), wv = tid >> 6, lane = tid & 63;
    float* qs = sm + wv * 384; float* ps = qs + 128;
    for (int it = blockIdx.x; it < M / 2; it += gridDim.x) {
        const int t = it * 2 + (wv >> 2), hd = wv & 3, b = t / SEQ;
        qs[lane] = bf2f(hb[(size_t)t * INW + POOLW + 2 * LRUW + hd * 128 + lane]); qs[lane + 64] = bf2f(hb[(size_t)t * INW + POOLW + 2 * LRUW + hd * 128 + lane + 64]);
        __syncthreads();
        float sc[4];
#pragma unroll
        for (int j = 0; j < 4; ++j) { const int key = lane + 64 * j; const bf16_t* kr = kb + ((size_t)(b * 4 + hd) * MEMLEN + key) * 128; float s = 0.f;
            for (int d = 0; d < 128; ++d) s = fmaf(qs[d], bf2f(kr[d]), s);
            sc[j] = s * 0.08838834764831845f; }
        const float mx = wave_max(fmaxf(fmaxf(sc[0], sc[1]), fmaxf(sc[2], sc[3])));
        float e[4], es = 0.f;
#pragma unroll
        for (int j = 0; j < 4; ++j) { e[j] = __expf(sc[j] - mx); es += e[j]; }
        const float inv = 1.f / wave_sum(es);
#pragma unroll
        for (int j = 0; j < 4; ++j) ps[lane + 64 * j] = e[j] * inv;
        __syncthreads();
#pragma unroll
        for (int q = 0; q < 2; ++q) { const int d = lane + 64 * q; const bf16_t* vr = vt + ((size_t)(b * 4 + hd) * 128 + d) * MEMLEN; float o = 0.f;
            for (int key = 0; key < MEMLEN; ++key) o = fmaf(ps[key], bf2f(vr[permkey(key)]), o);
            ymem[(size_t)t * MEMW + hd * 128 + d] = o; }
        __syncthreads();
    }
}
template <bool DO_POOL, bool DO_LRU, bool DO_MEM> DEVI void s2e_norm(const P& p, float* sm) {
    const float* ypool = (const float*)(p.ws + WS_YPOOL); const float* ylru = (const float*)(p.ws + WS_YLRU); const float* ymem = (const float*)(p.ws + WS_YMEM);
    const float* g = p.in[I_MIXG]; bf16_t* mix = (bf16_t*)(p.ws + WS_MIX);
    const int tid = opaque_tid(), wv = tid >> 6, lane = tid & 63;
    for (int t = blockIdx.x; t < M; t += gridDim.x) {
        const float a = ypool[(size_t)t * POOLW + tid], b0 = ylru[(size_t)t * LRUW + tid], b1 = ylru[(size_t)t * LRUW + tid + NT], c = ymem[(size_t)t * MEMW + tid];
        const float s0 = wave_sum(a * a), s1 = wave_sum(b0 * b0 + b1 * b1), s2 = wave_sum(c * c);
        if (lane == 0) { sm[wv] = s0; sm[8 + wv] = s1; sm[16 + wv] = s2; }
        __syncthreads();
        float t0 = 0.f, t1 = 0.f, t2 = 0.f;
#pragma unroll
        for (int i = 0; i < 8; ++i) { t0 += sm[i]; t1 += sm[8 + i]; t2 += sm[16 + i]; }
        const float r0 = rsqrtf(t0 / POOLW + EPS), r1 = rsqrtf(t1 / LRUW + EPS), r2 = rsqrtf(t2 / MEMW + EPS);
        bf16_t* mr = mix + (size_t)t * MIXW;
        if (DO_POOL) mr[tid] = f2bf(a * r0 * g[tid]);
        if (DO_LRU) { mr[POOLW + tid] = f2bf(b0 * r1 * g[POOLW + tid]); mr[POOLW + NT + tid] = f2bf(b1 * r1 * g[POOLW + NT + tid]); }
        if (DO_MEM) mr[POOLW + LRUW + tid] = f2bf(c * r2 * g[POOLW + LRUW + tid]);
        __syncthreads();
    }
}
DEVI void s3_outproj(const P& p, float* sm) {
    const float* x = p.in[I_X]; const float* w = p.in[I_WOUT]; const bf16_t* mix = (const bf16_t*)(p.ws + WS_MIX); float* z = p.out;
    const int ntn = D / 64, nt = (M / 128) * ntn;
    for (int it = blockIdx.x; it < nt; it += gridDim.x) {
        const int m0 = (it / ntn) * 128, n0 = (it % ntn) * 64;
        auto al = [&](int r, int k) { return bf2f(mix[(size_t)r * MIXW + k]); };
        auto bl = [&](int k, int n) { return w[(size_t)k * D + n]; };
        auto ep = [&](int r, int n, float v, float) { z[(size_t)r * D + n] = fmaf(ALPHA, x[(size_t)r * D + n], v); };
        sgemm_tile<false>(m0, n0, MIXW, al, bl, bl, ep, sm);
    }
}
DEVI void s4a_route(const P& p, float*) {
    const float* z = p.out; bf16_t* x1b = (bf16_t*)(p.ws + WS_X1B);
    const float* g1 = p.in[I_LN1G]; const float* b1 = p.in[I_LN1B]; const float* wg = p.in[I_WGROUP]; const float* bg = p.in[I_BGROUP]; const float* wf = p.in[I_WFINE]; const float* bfine = p.in[I_BFINE];
    int* cnt = (int*)(p.ws + WS_CTL) + CW_CNT; int* asg_e = (int*)(p.ws + WS_ASG_E); int* asg_s = (int*)(p.ws + WS_ASG_S); float* asg_w = (float*)(p.ws + WS_ASG_W);
    const int tid = opaque_tid(), wv = tid >> 6, lane = tid & 63;
    for (int t = blockIdx.x * 8 + wv; t < M; t += gridDim.x * 8) {
        float v[32]; float s = 0.f;
#pragma unroll
        for (int j = 0; j < 8; ++j) { const float4 q = *(const float4*)(z + (size_t)t * D + j * 256 + lane * 4); v[4 * j] = q.x; v[4 * j + 1] = q.y; v[4 * j + 2] = q.z; v[4 * j + 3] = q.w; s += (q.x + q.y) + (q.z + q.w); }
        const float mean = wave_sum(s) * (1.f / D); float s2 = 0.f;
#pragma unroll
        for (int i = 0; i < 32; ++i) { v[i] -= mean; s2 = fmaf(v[i], v[i], s2); }
        const float rstd = rsqrtf(wave_sum(s2) * (1.f / D) + EPS);
#pragma unroll
        for (int j = 0; j < 8; ++j) {
#pragma unroll
            for (int i = 0; i < 4; ++i) { const int k = j * 256 + lane * 4 + i; v[4 * j + i] = v[4 * j + i] * rstd * g1[k] + b1[k]; }
            ushort4 o; o.x = f2bf(v[4 * j]); o.y = f2bf(v[4 * j + 1]); o.z = f2bf(v[4 * j + 2]); o.w = f2bf(v[4 * j + 3]);
            *(ushort4*)(x1b + (size_t)t * D + j * 256 + lane * 4) = o; }
        float lg[4], lf[32];
#pragma unroll
        for (int o = 0; o < 4; ++o) lg[o] = 0.f;
#pragma unroll
        for (int o = 0; o < 32; ++o) lf[o] = 0.f;
#pragma unroll
        for (int j = 0; j < 8; ++j) {
#pragma unroll
            for (int i = 0; i < 4; ++i) { const int k = j * 256 + lane * 4 + i; const float xv = v[4 * j + i];
                const float4 g4 = *(const float4*)(wg + (size_t)k * NG);
                lg[0] = fmaf(xv, g4.x, lg[0]); lg[1] = fmaf(xv, g4.y, lg[1]); lg[2] = fmaf(xv, g4.z, lg[2]); lg[3] = fmaf(xv, g4.w, lg[3]);
#pragma unroll
                for (int q = 0; q < 8; ++q) { const float4 f4 = *(const float4*)(wf + (size_t)k * NE + 4 * q);
                    lf[4 * q] = fmaf(xv, f4.x, lf[4 * q]); lf[4 * q + 1] = fmaf(xv, f4.y, lf[4 * q + 1]); lf[4 * q + 2] = fmaf(xv, f4.z, lf[4 * q + 2]); lf[4 * q + 3] = fmaf(xv, f4.w, lf[4 * q + 3]); } }
            asm volatile("" ::: "memory");
        }
#pragma unroll
        for (int o = 0; o < 4; ++o) lg[o] = wave_sum(lg[o]) + bg[o];
#pragma unroll
        for (int o = 0; o < 32; ++o) lf[o] = wave_sum(lf[o]);
        int gi = 0; float gm = lg[0];
#pragma unroll
        for (int o = 1; o < 4; ++o) if (lg[o] > gm) { gm = lg[o]; gi = o; }
        float ge = 0.f;
#pragma unroll
        for (int o = 0; o < 4; ++o) ge += __expf(lg[o] - gm);
        const float gp = 1.f / ge;
        float fs[8];
#pragma unroll
        for (int j = 0; j < 8; ++j) { float q = lf[j];
#pragma unroll
            for (int o = 1; o < 4; ++o) q = (gi == o) ? lf[o * 8 + j] : q;
            fs[j] = q + bfine[gi * 8 + j]; }
        int i0 = 0; float l0 = fs[0];
#pragma unroll
        for (int j = 1; j < 8; ++j) if (fs[j] > l0) { l0 = fs[j]; i0 = j; }
        int i1 = -1; float l1 = -3.0e38f;
#pragma unroll
        for (int j = 0; j < 8; ++j) if (j != i0 && fs[j] > l1) { l1 = fs[j]; i1 = j; }
        const float e1 = __expf(l1 - l0), w0 = gp / (1.f + e1), w1 = gp * e1 / (1.f + e1);
        if (lane == 0) {
            const int ea = gi * 8 + i0, eb = gi * 8 + i1;
            const int sa = atomicAdd(&cnt[ea], 1), sb = atomicAdd(&cnt[eb], 1);
            asg_e[2 * t] = ea; asg_e[2 * t + 1] = eb; asg_s[2 * t] = sa; asg_s[2 * t + 1] = sb; asg_w[2 * t] = w0; asg_w[2 * t + 1] = w1;
        }
    }
}
DEVI void load_offs(const P& p, int* offs) {
    const int* cnt = (const int*)(p.ws + WS_CTL) + CW_CNT;
    if (threadIdx.x == 0) { int o = 0; for (int e = 0; e < NE; ++e) { offs[e] = o; o += (cnt[e] + 255) / 256 * 256; } offs[NE] = o; }
    __syncthreads();
}
DEVI void s4b_gather(const P& p, float* sm) {
    int* offs = (int*)sm; load_offs(p, offs);
    const bf16_t* x1b = (const bf16_t*)(p.ws + WS_X1B); bf16_t* xg = (bf16_t*)(p.ws + WS_XG);
    const int* asg_e = (const int*)(p.ws + WS_ASG_E); const int* asg_s = (const int*)(p.ws + WS_ASG_S); int* asg_r = (int*)(p.ws + WS_ASG_R);
    const int tid = opaque_tid(), wv = tid >> 6, lane = tid & 63;
    for (int t = blockIdx.x * 8 + wv; t < M; t += gridDim.x * 8) {
        const uint4 a = *(const uint4*)(x1b + (size_t)t * D + lane * 8), b = *(const uint4*)(x1b + (size_t)t * D + 512 + lane * 8),
                    c = *(const uint4*)(x1b + (size_t)t * D + 1024 + lane * 8), d = *(const uint4*)(x1b + (size_t)t * D + 1536 + lane * 8);
#pragma unroll
        for (int k = 0; k < 2; ++k) { const int row = offs[asg_e[2 * t + k]] + asg_s[2 * t + k]; bf16_t* dst = xg + (size_t)row * D;
            *(uint4*)(dst + lane * 8) = a; *(uint4*)(dst + 512 + lane * 8) = b; *(uint4*)(dst + 1024 + lane * 8) = c; *(uint4*)(dst + 1536 + lane * 8) = d;
            if (lane == 0) asg_r[2 * t + k] = row; }
    }
}
DEVI int expert_of_row(const int* offs, int row) { int e = 0; for (int i = 1; i < NE; ++i) if (row >= offs[i]) e = i; return e; }
DEVI float silu_(float v) { return v / (1.f + __expf(-v)); }
DEVI void s5_expert1(const P& p, float* sm) {
    int* offs = (int*)(sm + 8192); load_offs(p, offs);
    const bf16_t* xg = (const bf16_t*)(p.ws + WS_XG); bf16_t* hd = (bf16_t*)(p.ws + WS_HD);
    const int ntn = FF / 64, nt = (offs[NE] / 128) * ntn;
    for (int it = blockIdx.x; it < nt; it += gridDim.x) {
        const int m0 = (it / ntn) * 128, n0 = (it % ntn) * 64, e = expert_of_row(offs, m0);
        const float* wgt = p.in[I_WGATE] + (size_t)e * D * FF; const float* wup = p.in[I_WUP] + (size_t)e * D * FF;
        auto al = [&](int r, int k) { return bf2f(xg[(size_t)r * D + k]); };
        auto bl = [&](int k, int n) { return wgt[(size_t)k * FF + n]; };
        auto bl2 = [&](int k, int n) { return wup[(size_t)k * FF + n]; };
        auto ep = [&](int r, int n, float g, float u) { hd[(size_t)r * FF + n] = f2bf(silu_(g) * u); };
        sgemm_tile<true>(m0, n0, D, al, bl, bl2, ep, sm);
    }
}
DEVI void s6_expert2(const P& p, float* sm) {
    int* offs = (int*)(sm + 8192); load_offs(p, offs);
    const bf16_t* hd = (const bf16_t*)(p.ws + WS_HD); bf16_t* yb = (bf16_t*)(p.ws + WS_YB);
    const int ntn = D / 64, nt = (offs[NE] / 128) * ntn;
    for (int it = blockIdx.x; it < nt; it += gridDim.x) {
        const int m0 = (it / ntn) * 128, n0 = (it % ntn) * 64, e = expert_of_row(offs, m0);
        const float* wd = p.in[I_WDOWN] + (size_t)e * FF * D;
        auto al = [&](int r, int k) { return bf2f(hd[(size_t)r * FF + k]); };
        auto bl = [&](int k, int n) { return wd[(size_t)k * D + n]; };
        auto ep = [&](int r, int n, float v, float) { yb[(size_t)r * D + n] = f2bf(v); };
        sgemm_tile<false>(m0, n0, FF, al, bl, bl, ep, sm);
    }
}
DEVI void s7_final(const P& p, float*) {
    const bf16_t* x1b = (const bf16_t*)(p.ws + WS_X1B); const bf16_t* yb = (const bf16_t*)(p.ws + WS_YB);
    const int* asg_r = (const int*)(p.ws + WS_ASG_R); const float* asg_w = (const float*)(p.ws + WS_ASG_W);
    const float* g2 = p.in[I_LN2G]; const float* b2 = p.in[I_LN2B]; float* out = p.out;
    const int tid = opaque_tid(), wv = tid >> 6, lane = tid & 63;
    for (int t = blockIdx.x * 8 + wv; t < M; t += gridDim.x * 8) {
        const int r0 = asg_r[2 * t], r1 = asg_r[2 * t + 1]; const float w0 = asg_w[2 * t], w1 = asg_w[2 * t + 1];
        float v[32]; float s = 0.f;
#pragma unroll
        for (int j = 0; j < 8; ++j) { const int k = j * 256 + lane * 4;
            const ushort4 a = *(const ushort4*)(x1b + (size_t)t * D + k), y0 = *(const ushort4*)(yb + (size_t)r0 * D + k), y1 = *(const ushort4*)(yb + (size_t)r1 * D + k);
            v[4 * j] = ALPHA * bf2f(a.x) + w0 * bf2f(y0.x) + w1 * bf2f(y1.x); v[4 * j + 1] = ALPHA * bf2f(a.y) + w0 * bf2f(y0.y) + w1 * bf2f(y1.y);
            v[4 * j + 2] = ALPHA * bf2f(a.z) + w0 * bf2f(y0.z) + w1 * bf2f(y1.z); v[4 * j + 3] = ALPHA * bf2f(a.w) + w0 * bf2f(y0.w) + w1 * bf2f(y1.w);
            s += (v[4 * j] + v[4 * j + 1]) + (v[4 * j + 2] + v[4 * j + 3]); }
        const float mean = wave_sum(s) * (1.f / D); float s2 = 0.f;
#pragma unroll
        for (int i = 0; i < 32; ++i) { v[i] -= mean; s2 = fmaf(v[i], v[i], s2); }
        const float rstd = rsqrtf(wave_sum(s2) * (1.f / D) + EPS);
#pragma unroll
        for (int j = 0; j < 8; ++j) { const int k = j * 256 + lane * 4; const float4 g = *(const float4*)(g2 + k), b = *(const float4*)(b2 + k);
            float4 o; o.x = v[4 * j] * rstd * g.x + b.x; o.y = v[4 * j + 1] * rstd * g.y + b.y; o.z = v[4 * j + 2] * rstd * g.z + b.z; o.w = v[4 * j + 3] * rstd * g.w + b.w;
            *(float4*)(out + (size_t)t * D + k) = o; }
    }
}

constexpr int NSTAGE = 12;
template <int S> DEVI void run_stage(const P& p, float* sm) {
    if (S == 0) s1_inproj(p, sm);
    if (S == 1) s2a_pool(p, sm);
    if (S == 2) s2b_lru(p, sm);
    if (S == 3) s2c_scan(p, sm);
    if (S == 4) s2d_attn(p, sm);
    if (S == 5) s2e_norm<true, true, false>(p, sm);
    if (S == 6) s3_outproj(p, sm);
    if (S == 7) s4a_route(p, sm);
    if (S == 8) s4b_gather(p, sm);
    if (S == 9) s5_expert1(p, sm);
    if (S == 10) s6_expert2(p, sm);
    if (S == 11) s7_final(p, sm);
}

constexpr int LDS_BYTES = 144 * 1024;
__global__ void __launch_bounds__(NT, 2) mega_fwd(P p) {
    extern __shared__ __attribute__((aligned(16))) unsigned char lds[];
    float* sm = (float*)lds;
    cg::grid_group grid = cg::this_grid();
    p0_prologue(p, lds); __syncthreads(); p0_kv(p, lds); run_stage<0>(p, sm); grid.sync();
    p1_inproj(p, lds); grid.sync();
    for (int tile = blockIdx.x; tile < M / 64; tile += gridDim.x) { p2_lru_local(p, tile); p2_pool(p, lds, tile); p2_attn(p, lds, tile); }
    grid.sync();
    for (int tile = blockIdx.x; tile < M / 64; tile += gridDim.x) p2_lru_final(p, lds, tile);
    grid.sync();
    p3_outproj(p, lds); grid.sync();
    run_stage<7>(p, sm); grid.sync();
    run_stage<8>(p, sm); grid.sync();
    p5_expert1(p, lds); grid.sync();
    p6_expert2(p, lds); grid.sync();
    run_stage<11>(p, sm);
}
template <int S> __global__ void __launch_bounds__(NT, 2) stage_kernel(P p) {
    extern __shared__ __attribute__((aligned(16))) unsigned char lds[];
    run_stage<S>(p, (float*)lds);
}

extern "C" void kernel_launch(void* const* d_in, const int* in_sizes, int n_in, void* d_out, int out_size, void* d_ws, size_t ws_size, hipStream_t stream) {
    static int grid = 0;
    if (grid == 0) {
        if (n_in != 26 || out_size != M * D || ws_size < WS_END) { fprintf(stderr, "kernel_launch: unexpected shapes: n_in %d out %d ws %zu (need %zu)\n", n_in, out_size, ws_size, (size_t)WS_END); grid = -1; return; }
        int dev = 0, cus = 0, per_cu = 0;
        (void)hipGetDevice(&dev); (void)hipDeviceGetAttribute(&cus, hipDeviceAttributeMultiprocessorCount, dev);
        (void)hipFuncSetAttribute((const void*)mega_fwd, hipFuncAttributeMaxDynamicSharedMemorySize, LDS_BYTES);
        (void)hipOccupancyMaxActiveBlocksPerMultiprocessor(&per_cu, (const void*)mega_fwd, NT, LDS_BYTES);
        if (per_cu < 1) { fprintf(stderr, "kernel_launch: occupancy query says %d blocks per CU\n", per_cu); per_cu = 1; }
        grid = cus;
        fprintf(stderr, "kernel_launch: cus %d per_cu %d grid %d ws %zu\n", cus, per_cu, grid, ws_size);
    }
    if (grid < 0) return;
    (void)hipMemsetAsync((char*)d_ws + WS_CTL, 0, 1 * MiB, stream);
    P p{};
    for (int i = 0; i < 26; ++i) p.in[i] = (const float*)d_in[i];
    p.out = (float*)d_out; p.ws = (unsigned char*)d_ws;
#if ONE_LAUNCH
    void* args[] = {&p};
    hipError_t e = hipLaunchCooperativeKernel((const void*)mega_fwd, dim3(grid), dim3(NT), args, LDS_BYTES, stream);
    if (e != hipSuccess) fprintf(stderr, "cooperative launch failed: %s (grid %d)\n", hipGetErrorString(e), grid);
#else
    const int g2 = grid * 1;
#define LAUNCH(S) do { hipFuncSetAttribute((const void*)stage_kernel<S>, hipFuncAttributeMaxDynamicSharedMemorySize, LDS_BYTES); hipLaunchKernelGGL(stage_kernel<S>, dim3(g2), dim3(NT), LDS_BYTES, stream, p); } while (0)
    LAUNCH(0); LAUNCH(1); LAUNCH(2); LAUNCH(4); LAUNCH(3); LAUNCH(5); LAUNCH(6); LAUNCH(7); LAUNCH(8); LAUNCH(9); LAUNCH(10); LAUNCH(11);
#endif
}
```

```cpp
#include <hip/hip_runtime.h>
#include <hip/hip_cooperative_groups.h>
#include <cstdio>
#include <cstdint>
namespace cg = cooperative_groups;

#define DEVI __device__ __forceinline__
__device__ __forceinline__ int opaque_tid() { int t = threadIdx.x; asm volatile("" : "+v"(t)); return t; }
#ifndef NAIVE_KV
#define NAIVE_KV 0
#endif
#ifndef NAIVE_INPROJ
#define NAIVE_INPROJ 0
#endif
#ifndef ONE_LAUNCH
#define ONE_LAUNCH 1
#endif

constexpr int D = 2048, BATCH = 2, SEQ = 8192, M = BATCH * SEQ, MEMLEN = 256;
constexpr int POOLW = 512, LRUW = 1024, MEMW = 512, MIXW = 2048, INW = 3072;
constexpr int NG = 4, EPG = 8, NE = 32, FF = 1024;
constexpr float ALPHA = 1.189207115002721f;
constexpr float EPS = 1e-5f;
constexpr int NT = 512;

constexpr size_t MiB = 1u << 20;
constexpr size_t WS_CTL = 0;
constexpr size_t WS_KB = 1 * MiB, WS_VT = 1 * MiB + 512 * 1024;
constexpr size_t WS_ASG_E = 2 * MiB, WS_ASG_S = WS_ASG_E + 128 * 1024, WS_ASG_W = WS_ASG_S + 128 * 1024, WS_ASG_R = WS_ASG_W + 128 * 1024;
constexpr size_t WS_AGG = 4 * MiB;
constexpr size_t WS_WPT = 8 * MiB, WS_WAT = WS_WPT + 128 * 1024, WS_WXT = WS_WAT + 256 * 1024;
constexpr size_t WS_WRH = 9 * MiB, WS_WRL = WS_WRH + 256 * 1024;
constexpr size_t WS_HC = 424 * MiB;
constexpr size_t WS_WGU = 16 * MiB;
constexpr size_t WS_WD = 272 * MiB;
constexpr size_t WS_WIN = 400 * MiB;
constexpr size_t WS_WOUT = 412 * MiB;
constexpr size_t WS_XB = 424 * MiB;
constexpr size_t WS_X1B = 424 * MiB;
constexpr size_t WS_HB = 488 * MiB;
constexpr size_t WS_MIX = 584 * MiB;
constexpr size_t WS_XG = 488 * MiB;
constexpr size_t WS_HD = 652 * MiB;
constexpr size_t WS_YB = 488 * MiB;
constexpr size_t WS_TMP = 652 * MiB;
constexpr size_t WS_YPOOL = WS_TMP, WS_AS = WS_TMP + 32 * MiB, WS_BS = WS_AS + 64 * MiB, WS_YLRU = WS_BS + 64 * MiB, WS_YMEM = WS_YLRU + 64 * MiB;
constexpr size_t WS_END = WS_YMEM + 32 * MiB;
constexpr int ROWS_MAX = 2 * M + NE * 256;
constexpr int CW_CNT = 64;

typedef unsigned short bf16_t;
DEVI float bf2f(bf16_t v) { return __uint_as_float(((unsigned)v) << 16); }
DEVI bf16_t f2bf(float f) { unsigned u = __float_as_uint(f); return (bf16_t)((u + 0x7fffu + ((u >> 16) & 1u)) >> 16); }

struct P { const float* in[26]; float* out; unsigned char* ws; };
enum { I_X = 0, I_MEM, I_WIN, I_WPOOL, I_PSCALE, I_CONVW, I_CONVB, I_WA, I_BA, I_WX, I_BX, I_LAM, I_WKV, I_MIXG, I_WOUT, I_LN1G, I_LN1B,
       I_WGROUP, I_BGROUP, I_WFINE, I_BFINE, I_WGATE, I_WUP, I_WDOWN, I_LN2G, I_LN2B };

DEVI float wave_sum(float v) {
#pragma unroll
    for (int o = 1; o < 64; o <<= 1) v += __shfl_xor(v, o);
    return v;
}
DEVI float wave_max(float v) {
#pragma unroll
    for (int o = 1; o < 64; o <<= 1) v = fmaxf(v, __shfl_xor(v, o));
    return v;
}
DEVI int permkey(int key) { const int k = key & 31; return (key & ~31) | (k & 16) | (((k >> 2) & 1) << 3) | (((k >> 3) & 1) << 2) | (k & 3); }

namespace pg8 {
#define PG8_LAS __attribute__((address_space(3)))
typedef unsigned short bf16_t;
typedef short bf16x8 __attribute__((ext_vector_type(8)));
typedef float f32x4 __attribute__((ext_vector_type(4)));
typedef unsigned u32x4 __attribute__((ext_vector_type(4)));
constexpr int BM = 256, BK = 64, HALF = 128, HTB = HALF * BK * 2  , STAGE_BYTES = 8 * HTB, NXCD = 8, WGM = 8;

__host__ __device__ __forceinline__ int lds_byte(int r, int c) { const int st = (r >> 4) * 2 + (c >> 5), rr = r & 15, cc = c & 31, ob = rr * 64 + cc * 2; return st * 1024 + (ob ^ (((ob >> 9) & 1) << 5)); }
__host__ __device__ __forceinline__ void stage_rc(int b, int& R, int& C) { const int st = b / 1024, sb = b % 1024, swz = sb ^ (((sb >> 9) & 1) << 5); R = (st >> 1) * 16 + swz / 64; C = (st & 1) * 32 + (swz % 64) / 2; }
__host__ __device__ __forceinline__ int perm32(int rho) { const int n = rho >> 4, i = rho & 15; return 8 * (i >> 2) + 4 * n + (i & 3); }

struct Unit { int pm, pn; };
struct Gemm { const bf16_t* A; const bf16_t* Bt; int M, N, K; };

struct StaticOrder {
    int nM, nN, nwg, G, c;
    __host__ __device__ void init(int M, int N, int G_, int c_) { nM = M / BM; nN = N / BM; nwg = nM * nN; G = G_; c = c_; }
    __host__ __device__ bool next(int i, Unit& u) const {
        const long L = (long)i * G + c; if (L >= nwg) return false;
        int wgid = (int)L; { const int q = nwg / NXCD, r = nwg % NXCD, xcd = wgid % NXCD, off = wgid / NXCD; wgid = (xcd < r ? xcd * (q + 1) : r * (q + 1) + (xcd - r) * q) + off; }
        const int nig = WGM * nN, gid = wgid / nig, fm = gid * WGM, gsz = (nM - fm) < WGM ? (nM - fm) : WGM;
        u.pm = fm + ((wgid % nig) % gsz); u.pn = (wgid % nig) / gsz; return true;
    }
    __device__ __forceinline__ void a_ready(const Unit&) const {}
    __device__ __forceinline__ void done(const Unit&) const {}
};

__device__ __forceinline__ unsigned cvt_pk_bf16(float lo, float hi) { unsigned r; asm volatile("v_cvt_pk_bf16_f32 %0, %1, %2" : "=v"(r) : "v"(lo), "v"(hi)); return r; }
typedef float f32x2 __attribute__((ext_vector_type(2)));
__device__ __forceinline__ f32x2 gelu_pk(f32x2 v) {
    const f32x2 av = __builtin_elementwise_abs(v), d = av * 0.2316418882f + 1.0f;
    f32x2 t; t.x = __builtin_amdgcn_rcpf(d.x); t.y = __builtin_amdgcn_rcpf(d.y);
    f32x2 q = t * 0.5307027145f + (-0.7265760135f); q = q * t + 0.7107068705f; q = q * t + (-0.142248368f); q = q * t + 0.127414796f; q = q * t;
    const f32x2 s = (v * v) * (-0.72134752044f);
    f32x2 e; e.x = __builtin_amdgcn_exp2f(s.x); e.y = __builtin_amdgcn_exp2f(s.y);
    const f32x2 m = v * (q * e), r = v - m;
    f32x2 o; o.x = v.x < 0.f ? m.x : r.x; o.y = v.y < 0.f ? m.y : r.y; return o;
}

template <int ACT  > struct EpiBf16 {
    static constexpr bool PERM = true, AFTER_DRAIN = false; static_assert(ACT == 0 || ACT == 1, "EpiBf16: ACT is 0 (none) or 1 (gelu_pk)");
    bf16_t* O; int ldc; const float* bias; int split_cols; size_t split_stride; float scale0;
    __device__ __forceinline__ void operator()(const f32x4 (&acc)[2][2][4][2], const Unit& u, int wr, int wc, int fr, int fq) const {
        const int row0 = u.pm * BM + wr * 64 + fr; int colt = u.pn * BM; bf16_t* base = O;
        float sc = 1.f; if (split_cols) { const int t = colt / split_cols; base += (size_t)t * split_stride; colt -= t * split_cols; if (t == 0) sc = scale0; }
        const int col0 = colt + wc * 32 + 8 * fq, bcol0 = u.pn * BM + wc * 32 + 8 * fq;
        f32x4 bv[2][2];
#pragma unroll
        for (int bj = 0; bj < 2; ++bj)
#pragma unroll
            for (int n = 0; n < 2; ++n) bv[bj][n] = bias ? *(const f32x4*)(bias + bcol0 + bj * HALF + 4 * n) : (f32x4){0.f, 0.f, 0.f, 0.f};
#pragma unroll
        for (int ai = 0; ai < 2; ++ai)
#pragma unroll
            for (int m = 0; m < 4; ++m) { bf16_t* rowp = base + (size_t)(row0 + ai * HALF + m * 16) * ldc + col0;
#pragma unroll
                for (int bj = 0; bj < 2; ++bj) { f32x4 v0 = acc[ai][bj][m][0] + bv[bj][0], v1 = acc[ai][bj][m][1] + bv[bj][1];
                    if (ACT == 1) { f32x2 a = gelu_pk((f32x2){v0[0], v0[1]}), b = gelu_pk((f32x2){v0[2], v0[3]}), c = gelu_pk((f32x2){v1[0], v1[1]}), d = gelu_pk((f32x2){v1[2], v1[3]});
                        v0 = (f32x4){a.x, a.y, b.x, b.y}; v1 = (f32x4){c.x, c.y, d.x, d.y}; }
                    v0 = v0 * sc; v1 = v1 * sc; u32x4 w; w.x = cvt_pk_bf16(v0[0], v0[1]); w.y = cvt_pk_bf16(v0[2], v0[3]); w.z = cvt_pk_bf16(v1[0], v1[1]); w.w = cvt_pk_bf16(v1[2], v1[3]);
                    *(u32x4*)(rowp + bj * HALF) = w; } }
    }
};

template <class Epi, class Sched, bool ALIGN_EPI = false, bool SP2 = false>
__device__ __forceinline__ void gemm_phase(PG8_LAS unsigned char* lds, const Gemm g, const Sched& S, const Epi& E) {
    const int tid = opaque_tid(), wid = __builtin_amdgcn_readfirstlane(tid >> 6), lane = tid & 63, wr = wid >> 2, wc = wid & 3, fr = lane & 15, fq = lane >> 4;
    const int K = g.K, nt = K / BK;
    unsigned voffA[2], voffB[2];
#pragma unroll
    for (int i = 0; i < 2; ++i) { int R, C; stage_rc(tid * 16 + i * 8192, R, C); const int Rb = Epi::PERM ? ((R & ~31) + perm32(R & 31)) : R;
        voffA[i] = (unsigned)(R * K + C) * 2u; voffB[i] = (unsigned)(Rb * K + C) * 2u; }
    const size_t kstep = (size_t)(BK * 2);
    const size_t hstep = (size_t)HALF * K * 2;
    const size_t tstep = 2 * hstep;
    const unsigned ldsw = (unsigned)wid * 1024u;
    const int aoff = lds_byte(wr * 64 + fr, fq * 8), boff = lds_byte(wc * 32 + fr, fq * 8);
#define PG8_SA(b, h) (((b) * 2 + (h)) * HTB)
#define PG8_SB(b, h) ((4 + (b) * 2 + (h)) * HTB)
#define PG8_STAGE(bufoff, gbase, voff) do { _Pragma("unroll") for (int _i = 0; _i < 2; ++_i) \
        __builtin_amdgcn_global_load_lds((const unsigned*)((const char*)(gbase) + (voff)[_i]), (PG8_LAS unsigned*)(lds + (bufoff) + ldsw + _i * 8192), 16, 0, 0); } while (0)
#define PG8_LDA(dst, b, h) do { _Pragma("unroll") for (int m = 0; m < 4; ++m) _Pragma("unroll") for (int k = 0; k < 2; ++k) dst[m][k] = *(const PG8_LAS bf16x8*)(lds + PG8_SA(b, h) + aoff + m * 2048 + k * 1024); } while (0)
#define PG8_LDB(dst, b, h) do { _Pragma("unroll") for (int n = 0; n < 2; ++n) _Pragma("unroll") for (int k = 0; k < 2; ++k) dst[n][k] = *(const PG8_LAS bf16x8*)(lds + PG8_SB(b, h) + boff + n * 2048 + k * 1024); } while (0)
#define PG8_MMA(ai, bj, At, Bt) do { __builtin_amdgcn_s_setprio(1); _Pragma("unroll") for (int m = 0; m < 4; ++m) _Pragma("unroll") for (int n = 0; n < 2; ++n) _Pragma("unroll") for (int k = 0; k < 2; ++k) \
        acc[ai][bj][m][n] = __builtin_amdgcn_mfma_f32_16x16x32_bf16(Bt[n][k], At[m][k], acc[ai][bj][m][n], 0, 0, 0); __builtin_amdgcn_s_setprio(0); } while (0)
#define PG8_WAIT_V(n) asm volatile("s_waitcnt vmcnt(" #n ")" ::: "memory")
#define PG8_WAIT_L(n) asm volatile("s_waitcnt lgkmcnt(" #n ")" ::: "memory")
#define PG8_BAR __builtin_amdgcn_s_barrier()
#define PG8_SCHED __builtin_amdgcn_sched_barrier(0)
    Unit cur, nxt; int ui = 0;
    if (!S.next(0, cur)) return;
    f32x4 acc[2][2][4][2];
#pragma unroll
    for (int a = 0; a < 2; ++a)
#pragma unroll
        for (int b = 0; b < 2; ++b)
#pragma unroll
            for (int m = 0; m < 4; ++m)
#pragma unroll
                for (int n = 0; n < 2; ++n) acc[a][b][m][n] = (f32x4){0.f, 0.f, 0.f, 0.f};
    bf16x8 At[4][2], B0[2][2], B1[2][2];
    const char* cA = (const char*)g.A + (size_t)cur.pm * tstep; const char* cB = (const char*)g.Bt + (size_t)cur.pn * tstep;
    S.a_ready(cur);
    if constexpr (SP2) {
        PG8_STAGE(PG8_SB(0, 0), cB, voffB); PG8_STAGE(PG8_SB(0, 1), cB + hstep, voffB); PG8_STAGE(PG8_SA(0, 0), cA, voffA); PG8_STAGE(PG8_SA(0, 1), cA + hstep, voffA);
        if (wr == 1) PG8_BAR;
        PG8_WAIT_V(2); PG8_BAR;
        PG8_STAGE(PG8_SB(1, 0), cB + kstep, voffB); PG8_STAGE(PG8_SA(1, 0), cA + kstep, voffA); PG8_STAGE(PG8_SB(1, 1), cB + hstep + kstep, voffB);
        PG8_WAIT_V(6); PG8_BAR;
    } else {
        PG8_STAGE(PG8_SB(0, 0), cB, voffB); PG8_STAGE(PG8_SA(0, 0), cA, voffA); PG8_STAGE(PG8_SB(0, 1), cB + hstep, voffB); PG8_STAGE(PG8_SA(0, 1), cA + hstep, voffA);
        if (wr == 1) PG8_BAR;
        PG8_WAIT_V(4); PG8_BAR;
        PG8_STAGE(PG8_SB(1, 0), cB + kstep, voffB); PG8_STAGE(PG8_SA(1, 0), cA + kstep, voffA); PG8_STAGE(PG8_SB(1, 1), cB + hstep + kstep, voffB);
        PG8_WAIT_V(6); PG8_BAR;
    }
    for (;;) {
        const bool has_next = S.next(ui + 1, nxt);
        const char* nA = has_next ? (const char*)g.A + (size_t)nxt.pm * tstep : cA; const char* nB = has_next ? (const char*)g.Bt + (size_t)nxt.pn * tstep : cB;
        for (int t = 0; t < nt; t += 2) {
            const bool last = (t == nt - 2);
            const char* a1 = cA + (size_t)(t + 1) * kstep;
            const char* a2 = last ? nA : cA + (size_t)(t + 2) * kstep; const char* b2 = last ? nB : cB + (size_t)(t + 2) * kstep;
            const char* a3 = a2 + kstep; const char* b3 = b2 + kstep;
            if (last && has_next) S.a_ready(nxt);
            if constexpr (SP2) {
            PG8_LDB(B0, 0, 0); PG8_LDB(B1, 0, 1); PG8_SCHED; PG8_LDA(At, 0, 0); PG8_STAGE(PG8_SA(1, 1), a1 + hstep, voffA);
            PG8_WAIT_V(8); PG8_WAIT_L(0); PG8_BAR; PG8_MMA(0, 0, At, B0); PG8_MMA(0, 1, At, B1); PG8_BAR; PG8_SCHED;
            PG8_LDA(At, 0, 1); PG8_STAGE(PG8_SB(0, 0), b2, voffB); PG8_STAGE(PG8_SB(0, 1), b2 + hstep, voffB); PG8_STAGE(PG8_SA(0, 0), a2, voffA);
            PG8_WAIT_V(8); PG8_WAIT_L(0); PG8_BAR; PG8_MMA(1, 0, At, B0); PG8_MMA(1, 1, At, B1); PG8_BAR; PG8_SCHED;
            PG8_LDB(B0, 1, 0); PG8_LDB(B1, 1, 1); PG8_SCHED; PG8_LDA(At, 1, 0); PG8_STAGE(PG8_SA(0, 1), a2 + hstep, voffA);
            PG8_WAIT_V(8); PG8_WAIT_L(0); PG8_BAR; PG8_MMA(0, 0, At, B0); PG8_MMA(0, 1, At, B1); PG8_BAR; PG8_SCHED;
            PG8_LDA(At, 1, 1); PG8_STAGE(PG8_SB(1, 0), b3, voffB); PG8_STAGE(PG8_SB(1, 1), b3 + hstep, voffB); PG8_STAGE(PG8_SA(1, 0), a3, voffA);
            PG8_WAIT_V(8); PG8_WAIT_L(0); PG8_BAR; PG8_MMA(1, 0, At, B0); PG8_MMA(1, 1, At, B1); PG8_BAR; PG8_SCHED;
            } else {
            PG8_LDB(B0, 0, 0); PG8_SCHED; PG8_LDA(At, 0, 0); PG8_STAGE(PG8_SA(1, 1), a1 + hstep, voffA);
            PG8_WAIT_L(8); PG8_BAR; PG8_WAIT_L(0); PG8_MMA(0, 0, At, B0); PG8_BAR; PG8_SCHED;
            PG8_LDB(B1, 0, 1); PG8_STAGE(PG8_SB(0, 0), b2, voffB);
            PG8_BAR; PG8_WAIT_L(0); PG8_MMA(0, 1, At, B1); PG8_BAR;
            PG8_LDA(At, 0, 1); PG8_STAGE(PG8_SA(0, 0), a2, voffA);
            PG8_BAR; PG8_WAIT_L(0); PG8_MMA(1, 0, At, B0); PG8_BAR; PG8_SCHED;
            PG8_STAGE(PG8_SB(0, 1), b2 + hstep, voffB);
            PG8_WAIT_V(6); PG8_BAR; PG8_MMA(1, 1, At, B1); PG8_BAR;
            PG8_LDB(B0, 1, 0); PG8_SCHED; PG8_LDA(At, 1, 0); PG8_STAGE(PG8_SA(0, 1), a2 + hstep, voffA);
            PG8_WAIT_L(8); PG8_BAR; PG8_WAIT_L(0); PG8_MMA(0, 0, At, B0); PG8_BAR; PG8_SCHED;
            PG8_LDB(B1, 1, 1); PG8_STAGE(PG8_SB(1, 0), b3, voffB);
            PG8_BAR; PG8_WAIT_L(0); PG8_MMA(0, 1, At, B1); PG8_BAR;
            PG8_LDA(At, 1, 1); PG8_STAGE(PG8_SA(1, 0), a3, voffA);
            PG8_BAR; PG8_WAIT_L(0); PG8_MMA(1, 0, At, B0); PG8_BAR; PG8_SCHED;
            PG8_STAGE(PG8_SB(1, 1), b3 + hstep, voffB);
            PG8_WAIT_V(6); PG8_BAR; PG8_MMA(1, 1, At, B1); PG8_BAR;
            }
        }
        if constexpr (ALIGN_EPI) { if (wr == 0) PG8_BAR; }
        if constexpr (!Epi::AFTER_DRAIN) { E(acc, cur, wr, wc, fr, fq); S.done(cur); }
        if (!has_next) break;
#pragma unroll
        for (int a = 0; a < 2; ++a)
#pragma unroll
            for (int b = 0; b < 2; ++b)
#pragma unroll
                for (int m = 0; m < 4; ++m)
#pragma unroll
                    for (int n = 0; n < 2; ++n) acc[a][b][m][n] = (f32x4){0.f, 0.f, 0.f, 0.f};
        cur = nxt; cA = nA; cB = nB; ++ui;
        if constexpr (ALIGN_EPI) { if (wr == 1) PG8_BAR; }
    }
    PG8_WAIT_V(0);
    if constexpr (!ALIGN_EPI) { if (wr == 0) PG8_BAR; }
    PG8_BAR;
    if constexpr (Epi::AFTER_DRAIN) { E.fused(acc, cur, wr, wc, fr, fq, lds, wid, lane); S.done(cur); }
#undef PG8_SA
#undef PG8_SB
#undef PG8_STAGE
#undef PG8_LDA
#undef PG8_LDB
#undef PG8_MMA
#undef PG8_WAIT_V
#undef PG8_WAIT_L
#undef PG8_BAR
#undef PG8_SCHED
}
}


#define LAS __attribute__((address_space(3)))
typedef unsigned v4u __attribute__((ext_vector_type(4)));
typedef float f32x4 __attribute__((ext_vector_type(4)));
DEVI unsigned pk2(float lo, float hi) { return (unsigned)f2bf(lo) | ((unsigned)f2bf(hi) << 16); }
constexpr int NWAVES = NT / 64;

struct EpiZ {
    static constexpr bool PERM = false, AFTER_DRAIN = false;
    const float* x; float* z; int ldc;
    __device__ __forceinline__ void operator()(const pg8::f32x4 (&acc)[2][2][4][2], const pg8::Unit& u, int wr, int wc, int fr, int fq) const {
        const int row0 = u.pm * pg8::BM + wr * 64 + fr, col0 = u.pn * pg8::BM + wc * 32 + 4 * fq;
#pragma unroll
        for (int ai = 0; ai < 2; ++ai)
#pragma unroll
            for (int m = 0; m < 4; ++m) { const size_t off = (size_t)(row0 + ai * pg8::HALF + m * 16) * ldc + col0;
#pragma unroll
                for (int bj = 0; bj < 2; ++bj)
#pragma unroll
                    for (int n = 0; n < 2; ++n) { const pg8::f32x4 xv = *(const pg8::f32x4*)(x + off + bj * pg8::HALF + n * 16);
                        *(pg8::f32x4*)(z + off + bj * pg8::HALF + n * 16) = xv * ALPHA + acc[ai][bj][m][n]; } }
    }
};

DEVI void transpose_item(const float* W, int ldn, int k0, int n0, bf16_t* dst, int K, LAS float* scr, int lane) {
    const int r = lane >> 3, q = lane & 7;
    f32x4 v[8];
#pragma unroll
    for (int i = 0; i < 8; ++i) v[i] = *(const f32x4*)(W + (size_t)(k0 + i * 8 + r) * ldn + n0 + 4 * q);
#pragma unroll
    for (int i = 0; i < 8; ++i) { LAS float* s = scr + (i * 8 + r) * 33 + 4 * q; s[0] = v[i][0]; s[1] = v[i][1]; s[2] = v[i][2]; s[3] = v[i][3]; }
    asm volatile("s_waitcnt lgkmcnt(0)" ::: "memory");
    const int c = lane & 7;
#pragma unroll
    for (int j = 0; j < 4; ++j) { const int n = (lane >> 3) + 8 * j; const LAS float* s = scr + (8 * c) * 33 + n;
        v4u o; o.x = pk2(s[0 * 33], s[1 * 33]); o.y = pk2(s[2 * 33], s[3 * 33]); o.z = pk2(s[4 * 33], s[5 * 33]); o.w = pk2(s[6 * 33], s[7 * 33]);
        *(v4u*)(dst + (size_t)n * K + 8 * c) = o; }
    asm volatile("s_waitcnt lgkmcnt(0)" ::: "memory");
}
DEVI void p0_prologue(const P& p, unsigned char* lds) {
    const int tid = opaque_tid(), wave = tid >> 6, lane = tid & 63;
    LAS float* scr = (LAS float*)((LAS unsigned char*)lds + wave * 16384);
    const int gw = blockIdx.x * NWAVES + wave, NGW = gridDim.x * NWAVES;
    bf16_t* win_t = (bf16_t*)(p.ws + WS_WIN); bf16_t* wout_t = (bf16_t*)(p.ws + WS_WOUT);
    constexpr int I_IN = (D / 64) * (INW / 32), I_OUT = (MIXW / 64) * (D / 32);
    constexpr int I_E = NE * (D / 64) * (FF / 32);
    bf16_t* wgu_t = (bf16_t*)(p.ws + WS_WGU); bf16_t* wd_t = (bf16_t*)(p.ws + WS_WD);
    for (int it = gw; it < 3 * I_E; it += NGW) {
        const int fam = it / I_E, r = it % I_E, e = r >> 10, q = r & 1023;
        if (fam < 2) { const int kb = q >> 5, nb = q & 31, n0 = nb * 32;
            transpose_item(p.in[fam == 0 ? I_WGATE : I_WUP] + (size_t)e * D * FF, FF, kb * 64, n0, wgu_t + ((size_t)e * 2048 + (n0 >> 7) * 256 + fam * 128 + (n0 & 127)) * D + kb * 64, D, scr, lane); }
        else { const int kb = q >> 6, nb = q & 63, n0 = nb * 32;
            transpose_item(p.in[I_WDOWN] + (size_t)e * FF * D, D, kb * 64, n0, wd_t + ((size_t)e * 2048 + n0) * FF + kb * 64, FF, scr, lane); }
    }
    for (int it = gw; it < 160; it += NGW) {
        const int mat = it >> 3, q = it & 7, kb = q >> 2, nb = q & 3;
        const float* src = mat < 4 ? p.in[I_WPOOL] + (size_t)mat * 16384 : (mat < 12 ? p.in[I_WA] + (size_t)(mat - 4) * 16384 : p.in[I_WX] + (size_t)(mat - 12) * 16384);
        bf16_t* dstm = mat < 4 ? (bf16_t*)(p.ws + WS_WPT) + (size_t)mat * 16384 : (mat < 12 ? (bf16_t*)(p.ws + WS_WAT) + (size_t)(mat - 4) * 16384 : (bf16_t*)(p.ws + WS_WXT) + (size_t)(mat - 12) * 16384);
        transpose_item(src, 128, kb * 64, nb * 32, dstm + (size_t)(nb * 32) * 128 + kb * 64, 128, scr, lane);
    }
    for (int it = gw; it < I_IN + I_OUT; it += NGW) {
        if (it < I_IN) { const int kb = it / (INW / 32), nb = it % (INW / 32); transpose_item(p.in[I_WIN], INW, kb * 64, nb * 32, win_t + (size_t)(nb * 32) * D + kb * 64, D, scr, lane); }
        else { const int r = it - I_IN, kb = r / (D / 32), nb = r % (D / 32); transpose_item(p.in[I_WOUT], D, kb * 64, nb * 32, wout_t + (size_t)(nb * 32) * MIXW + kb * 64, MIXW, scr, lane); }
    }
    {
        bf16_t* wrh = (bf16_t*)(p.ws + WS_WRH); bf16_t* wrl = (bf16_t*)(p.ws + WS_WRL);
        for (int i = blockIdx.x * NT + tid; i < 64 * D; i += gridDim.x * NT) { const int n = i >> 11, kk = i & (D - 1);
            const float w = n < NE ? p.in[I_WFINE][(size_t)kk * NE + n] : (n < NE + NG ? p.in[I_WGROUP][(size_t)kk * NG + (n - NE)] : 0.f);
            const bf16_t hi = f2bf(w); wrh[i] = hi; wrl[i] = f2bf(w - bf2f(hi)); }
    }
    const float* x = p.in[I_X]; bf16_t* xb = (bf16_t*)(p.ws + WS_XB);
    const size_t n8 = (size_t)M * D / 8;
    for (size_t i = (size_t)blockIdx.x * NT + tid; i < n8; i += (size_t)gridDim.x * NT) {
        const f32x4 a = *(const f32x4*)(x + i * 8), b = *(const f32x4*)(x + i * 8 + 4);
        v4u o; o.x = pk2(a[0], a[1]); o.y = pk2(a[2], a[3]); o.z = pk2(b[0], b[1]); o.w = pk2(b[2], b[3]);
        *(v4u*)(xb + i * 8) = o;
    }
}
DEVI void p1_inproj(const P& p, unsigned char* lds) {
    pg8::Gemm g{(const bf16_t*)(p.ws + WS_XB), (const bf16_t*)(p.ws + WS_WIN), M, INW, D}; pg8::StaticOrder S; S.init(M, INW, (int)gridDim.x, (int)blockIdx.x);
    pg8::EpiBf16<0> E{(bf16_t*)(p.ws + WS_HB), INW, nullptr, 0, 0, 1.f};
    pg8::gemm_phase<pg8::EpiBf16<0>, pg8::StaticOrder, true, true>((PG8_LAS unsigned char*)lds, g, S, E);
}
DEVI void p3_outproj(const P& p, unsigned char* lds) {
    pg8::Gemm g{(const bf16_t*)(p.ws + WS_MIX), (const bf16_t*)(p.ws + WS_WOUT), M, D, MIXW}; pg8::StaticOrder S; S.init(M, D, (int)gridDim.x, (int)blockIdx.x);
    EpiZ E{p.in[I_X], p.out, D};
    pg8::gemm_phase<EpiZ, pg8::StaticOrder, true, true>((PG8_LAS unsigned char*)lds, g, S, E);
}


constexpr int MOE_TAB_OFF = 131072;
struct MoeOrder {
    const LAS int* tab; int T, G, c;
    __device__ __forceinline__ bool next(int i, pg8::Unit& u) const {
        int mt, nt;
        if ((G & 63) == 0) { const int cpx = G >> 3, mpx = cpx >> 3, x = c & 7, j = c >> 3; mt = i * (G >> 3) + x * mpx + (j >> 3); nt = j & 7; }
        else { const int L = i * G + c; mt = L >> 3; nt = L & 7; }
        if (mt >= T) return false;
        u.pm = mt; u.pn = __builtin_amdgcn_readfirstlane(tab[64 + mt]) * 8 + nt; return true;
    }
    __device__ __forceinline__ void a_ready(const pg8::Unit&) const {}
    __device__ __forceinline__ void done(const pg8::Unit&) const {}
};
DEVI void moe_tables(const P& p, unsigned char* lds) {
    LAS int* tab = (LAS int*)((LAS unsigned char*)lds + MOE_TAB_OFF);
    const int* cnt = (const int*)(p.ws + WS_CTL) + CW_CNT;
    if (threadIdx.x == 0) { int o = 0, t = 0;
        for (int e = 0; e < NE; ++e) { tab[e] = o; const int nt = (cnt[e] + 255) >> 8; for (int q = 0; q < nt; ++q) tab[64 + t + q] = e; t += nt; o += nt * 256; }
        tab[NE] = o; tab[33] = t; }
    __syncthreads();
}
struct EpiGU {
    static constexpr bool PERM = true, AFTER_DRAIN = false;
    bf16_t* O;
    __device__ __forceinline__ void operator()(const pg8::f32x4 (&acc)[2][2][4][2], const pg8::Unit& u, int wr, int wc, int fr, int fq) const {
        const int row0 = u.pm * pg8::BM + wr * 64 + fr, col0 = (u.pn & 7) * 128 + wc * 32 + 8 * fq;
#pragma unroll
        for (int ai = 0; ai < 2; ++ai)
#pragma unroll
            for (int m = 0; m < 4; ++m) { bf16_t* rowp = O + (size_t)(row0 + ai * pg8::HALF + m * 16) * FF + col0;
                float h[8];
#pragma unroll
                for (int n = 0; n < 2; ++n)
#pragma unroll
                    for (int e = 0; e < 4; ++e) { const float g = acc[ai][0][m][n][e], up = acc[ai][1][m][n][e]; h[4 * n + e] = g * __builtin_amdgcn_rcpf(1.f + __expf(-g)) * up; }
                pg8::u32x4 w; w.x = pg8::cvt_pk_bf16(h[0], h[1]); w.y = pg8::cvt_pk_bf16(h[2], h[3]); w.z = pg8::cvt_pk_bf16(h[4], h[5]); w.w = pg8::cvt_pk_bf16(h[6], h[7]);
                *(pg8::u32x4*)rowp = w; }
    }
};
DEVI void p5_expert1(const P& p, unsigned char* lds) {
    moe_tables(p, lds);
    const LAS int* tab = (const LAS int*)((LAS unsigned char*)lds + MOE_TAB_OFF);
    MoeOrder S{tab, __builtin_amdgcn_readfirstlane(tab[33]), (int)gridDim.x, (int)blockIdx.x};
    pg8::Gemm g{(const bf16_t*)(p.ws + WS_XG), (const bf16_t*)(p.ws + WS_WGU), 0, 0, D};
    EpiGU E{(bf16_t*)(p.ws + WS_HD)};
    pg8::gemm_phase<EpiGU, MoeOrder, true, true>((PG8_LAS unsigned char*)lds, g, S, E);
}
DEVI void p6_expert2(const P& p, unsigned char* lds) {
    moe_tables(p, lds);
    const LAS int* tab = (const LAS int*)((LAS unsigned char*)lds + MOE_TAB_OFF);
    MoeOrder S{tab, __builtin_amdgcn_readfirstlane(tab[33]), (int)gridDim.x, (int)blockIdx.x};
    pg8::Gemm g{(const bf16_t*)(p.ws + WS_HD), (const bf16_t*)(p.ws + WS_WD), 0, 0, FF};
    pg8::EpiBf16<0> E{(bf16_t*)(p.ws + WS_YB), D, nullptr, 2048, 0, 1.f};
    pg8::gemm_phase<pg8::EpiBf16<0>, MoeOrder, true, true>((PG8_LAS unsigned char*)lds, g, S, E);
}


constexpr int CW_BAR = 4096;
#define XB_TMO      128
#define XB_XCNT(j)  (256  + 64 * (j))
#define XB_XSUB(j)  (1280 + 64 * (j))
#define XB_XGEN(j)  (2304 + 64 * (j))
#define XB_TOP      3328
#define XB_TOPGEN   3392
#define XCD_BAR_WORDS 3456
#define XB_SPIN_CAP (1u << 18)

__device__ __forceinline__ unsigned xb_ld(unsigned* p)              { return __hip_atomic_load(p, __ATOMIC_RELAXED, __HIP_MEMORY_SCOPE_AGENT); }
__device__ __forceinline__ unsigned xb_add(unsigned* p, unsigned v) { return __hip_atomic_fetch_add(p, v, __ATOMIC_RELAXED, __HIP_MEMORY_SCOPE_AGENT); }
__device__ __forceinline__ unsigned xb_xcc_id() { return (unsigned)__builtin_amdgcn_s_getreg((3 << 11) | 20) & 0xFu; }
#define XB_SPIN(cond, bar) do { unsigned _sp = 0; while (cond) { __builtin_amdgcn_s_sleep(1); \
    if ((++_sp & 255u) == 0u) { if (xb_ld(&(bar)[XB_TMO])) break; if (_sp > XB_SPIN_CAP) { atomicAdd(&(bar)[XB_TMO], 1u); break; } } } } while (0)

struct XcdBarrier {
    unsigned* bar; unsigned x;
    volatile LAS unsigned* st;
};

__device__ __forceinline__ XcdBarrier xcd_barrier_post(unsigned* bar, volatile LAS unsigned* st) {
    XcdBarrier b; b.bar = bar; b.x = xb_xcc_id(); b.st = st;
    if (threadIdx.x == 0) (void)xb_add(&bar[XB_XCNT(b.x)], 1u);
    return b;
}
__device__ __forceinline__ void xcd_barrier_complete(unsigned* bar, unsigned x, unsigned& nloc, unsigned& nx) {
    const unsigned G = gridDim.x * gridDim.y * gridDim.z;
    unsigned sum, cnt, mine, sp = 0u;
    for (;;) {
        sum = 0u; cnt = 0u; mine = 0u;
#pragma unroll
        for (unsigned j = 0; j < 16; ++j) { const unsigned c = xb_ld(&bar[XB_XCNT(j)]); sum += c; cnt += (c > 0u) ? 1u : 0u; mine = (j == x) ? c : mine; }
        if (sum == G) break;
        __builtin_amdgcn_s_sleep(1);
        if ((++sp & 255u) == 0u) { if (xb_ld(&bar[XB_TMO])) break; if (sp > XB_SPIN_CAP) { atomicAdd(&bar[XB_TMO], 1u); break; } }
    }
    nloc = mine > 0u ? mine : 1u; nx = cnt > 0u ? cnt : 1u;
}

__device__ __forceinline__ void xcd_barrier(const XcdBarrier& b) {
    asm volatile("s_waitcnt vmcnt(0)" ::: "memory");
    __syncthreads();
    if (threadIdx.x == 0) {
        unsigned* bar = b.bar;
        __builtin_amdgcn_s_waitcnt(0);
        unsigned nloc = b.st[0], nx = b.st[1];
        if (nloc == 0u) { xcd_barrier_complete(bar, b.x, nloc, nx); b.st[0] = nloc; b.st[1] = nx; }
        const unsigned old = xb_add(&bar[XB_XSUB(b.x)], 1u);
        const unsigned gen = old / nloc;
        if (old + 1u == (gen + 1u) * nloc) {
            __builtin_amdgcn_fence(__ATOMIC_RELEASE, "agent");
            asm volatile("s_waitcnt vmcnt(0)" ::: "memory");
            const unsigned og = xb_add(&bar[XB_TOP], 1u);
            const unsigned tg = og / nx;
            if (og + 1u == (tg + 1u) * nx) xb_add(&bar[XB_TOPGEN], 1u);
            else XB_SPIN(xb_ld(&bar[XB_TOPGEN]) == tg, bar);
            __builtin_amdgcn_fence(__ATOMIC_ACQUIRE, "agent");
            xb_add(&bar[XB_XGEN(b.x)], 1u);
            asm volatile("s_waitcnt vmcnt(0)" ::: "memory");
        } else {
            XB_SPIN(xb_ld(&bar[XB_XGEN(b.x)]) == gen, bar);
            __builtin_amdgcn_fence(__ATOMIC_ACQUIRE, "agent");
            asm volatile("s_waitcnt vmcnt(0)" ::: "memory");
        }
    }
    __syncthreads();
}

typedef short bf16x8 __attribute__((ext_vector_type(8)));
typedef float f32x16 __attribute__((ext_vector_type(16)));
typedef float f32x2_t __attribute__((ext_vector_type(2))); typedef __bf16 bf16x2_t __attribute__((ext_vector_type(2)));
DEVI unsigned cvtpk(float lo, float hi) { f32x2_t v = {lo, hi}; bf16x2_t b = __builtin_convertvector(v, bf16x2_t); return __builtin_bit_cast(unsigned, b); }
DEVI bf16x8 pack8(float a0, float a1, float a2, float a3, float a4, float a5, float a6, float a7) {
    v4u o; o.x = cvtpk(a0, a1); o.y = cvtpk(a2, a3); o.z = cvtpk(a4, a5); o.w = cvtpk(a6, a7); return __builtin_bit_cast(bf16x8, o); }
DEVI f32x16 zero16() { f32x16 z;
#pragma unroll
    for (int i = 0; i < 16; ++i) z[i] = 0.f; return z; }
#define MFMA32(a, b, c) __builtin_amdgcn_mfma_f32_32x32x16_bf16((a), (b), (c), 0, 0, 0)
DEVI float xhalf(float v) { return __shfl_xor(v, 32); }

DEVI void p0_kv(const P& p, unsigned char* lds) {
    const int tid = opaque_tid(), wave = tid >> 6, lane = tid & 63, r32 = lane & 31, hh = lane >> 5;
    const float* mem = p.in[I_MEM]; const float* wkv = p.in[I_WKV]; bf16_t* kb = (bf16_t*)(p.ws + WS_KB); bf16_t* vt = (bf16_t*)(p.ws + WS_VT);
    LAS float* red = (LAS float*)(LAS unsigned char*)lds;
    for (int blk = blockIdx.x; blk < 256; blk += gridDim.x) {
        const int rb = blk >> 4, cb = blk & 15, row0 = rb * 32, n0 = cb * 64;
        f32x16 acc0 = zero16(), acc1 = zero16();
        const float* arow = mem + (size_t)(row0 + r32) * D + wave * 256 + 8 * hh;
        const float* bcol = wkv + (size_t)(wave * 256 + 8 * hh) * (2 * MEMW) + n0 + r32;
#pragma unroll 2
        for (int ks = 0; ks < 16; ++ks) {
            const f32x4 a0 = *(const f32x4*)(arow + ks * 16), a1 = *(const f32x4*)(arow + ks * 16 + 4);
            float b0[8], b1[8];
#pragma unroll
            for (int j = 0; j < 8; ++j) { b0[j] = bcol[(size_t)(ks * 16 + j) * (2 * MEMW)]; b1[j] = bcol[(size_t)(ks * 16 + j) * (2 * MEMW) + 32]; }
            const bf16x8 af = pack8(a0[0], a0[1], a0[2], a0[3], a1[0], a1[1], a1[2], a1[3]);
            acc0 = MFMA32(af, pack8(b0[0], b0[1], b0[2], b0[3], b0[4], b0[5], b0[6], b0[7]), acc0);
            acc1 = MFMA32(af, pack8(b1[0], b1[1], b1[2], b1[3], b1[4], b1[5], b1[6], b1[7]), acc1);
        }
#pragma unroll
        for (int r = 0; r < 16; ++r) { red[(wave * 32 + r) * 64 + lane] = acc0[r]; red[(wave * 32 + 16 + r) * 64 + lane] = acc1[r]; }
        __syncthreads();
#pragma unroll
        for (int i = 0; i < 4; ++i) { const int e = tid + i * NT; float v = 0.f;
#pragma unroll
            for (int w = 0; w < 8; ++w) v += red[w * 2048 + e];
            const int tl = e >> 10, reg = (e >> 6) & 15, ln = e & 63;
            const int R = row0 + (reg & 3) + 8 * (reg >> 2) + 4 * (ln >> 5), n = n0 + 32 * tl + (ln & 31), b = R >> 8, key = R & 255;
            if (n < MEMW) { const int hd = n >> 7, d = n & 127; kb[((size_t)(b * 4 + hd) * MEMLEN + key) * 128 + d] = f2bf(v); }
            else { const int n2 = n - MEMW, hd = n2 >> 7, d = n2 & 127; vt[((size_t)(b * 4 + hd) * 128 + d) * MEMLEN + permkey(key)] = f2bf(v); } }
        __syncthreads();
    }
}

DEVI void p2_attn(const P& p, unsigned char* lds, int tile) {
    const int tid = opaque_tid(), wave = __builtin_amdgcn_readfirstlane(tid >> 6), lane = tid & 63, r32 = lane & 31, hh = lane >> 5;
    const int hd = wave >> 1, mt = wave & 1, t0 = tile * 64 + mt * 32, b = t0 / SEQ;
    const bf16_t* hb = (const bf16_t*)(p.ws + WS_HB); const bf16_t* kb = (const bf16_t*)(p.ws + WS_KB); const bf16_t* vt = (const bf16_t*)(p.ws + WS_VT); bf16_t* mix = (bf16_t*)(p.ws + WS_MIX);
    bf16x8 qf[8];
    const bf16_t* qrow = hb + (size_t)(t0 + r32) * INW + (POOLW + 2 * LRUW) + hd * 128 + hh * 8;
#pragma unroll
    for (int ks = 0; ks < 8; ++ks) qf[ks] = *(const bf16x8*)(qrow + ks * 16);
    f32x16 s[8];
    const bf16_t* kbase = kb + ((size_t)(b * 4 + hd) * MEMLEN + r32) * 128 + hh * 8;
#pragma unroll
    for (int kt = 0; kt < 8; ++kt) { s[kt] = zero16();
#pragma unroll
        for (int ks = 0; ks < 8; ++ks) { const bf16x8 kf = *(const bf16x8*)(kbase + (size_t)kt * 32 * 128 + ks * 16); s[kt] = MFMA32(kf, qf[ks], s[kt]); }
        asm volatile("" ::: "memory"); }
    float mx = -3.0e38f;
#pragma unroll
    for (int kt = 0; kt < 8; ++kt)
#pragma unroll
        for (int r = 0; r < 16; ++r) mx = fmaxf(mx, s[kt][r]);
    mx = fmaxf(mx, xhalf(mx));
    const float sc = 0.08838834764831845f * 1.4426950408889634f; float sum = 0.f;
#pragma unroll
    for (int kt = 0; kt < 8; ++kt)
#pragma unroll
        for (int r = 0; r < 16; ++r) { const float pv = __builtin_amdgcn_exp2f((s[kt][r] - mx) * sc); s[kt][r] = pv; sum += pv; }
    sum += xhalf(sum);
    const float inv = 1.f / sum;
    f32x16 o[4];
#pragma unroll
    for (int dt = 0; dt < 4; ++dt) o[dt] = zero16();
    const bf16_t* vbase = vt + ((size_t)(b * 4 + hd) * 128 + r32) * MEMLEN + hh * 8;
#pragma unroll
    for (int kt = 0; kt < 8; ++kt)
#pragma unroll
        for (int si = 0; si < 2; ++si) {
            const bf16x8 pf = pack8(s[kt][8 * si], s[kt][8 * si + 1], s[kt][8 * si + 2], s[kt][8 * si + 3], s[kt][8 * si + 4], s[kt][8 * si + 5], s[kt][8 * si + 6], s[kt][8 * si + 7]);
#pragma unroll
            for (int dt = 0; dt < 4; ++dt) { const bf16x8 vf = *(const bf16x8*)(vbase + (size_t)dt * 32 * MEMLEN + kt * 32 + si * 16); o[dt] = MFMA32(vf, pf, o[dt]); }
            asm volatile("" ::: "memory"); }
    float ss = 0.f;
#pragma unroll
    for (int dt = 0; dt < 4; ++dt)
#pragma unroll
        for (int r = 0; r < 16; ++r) { o[dt][r] *= inv; ss = fmaf(o[dt][r], o[dt][r], ss); }
    ss += xhalf(ss);
    LAS float* ssm = (LAS float*)(LAS unsigned char*)lds;
    if (hh == 0) ssm[wave * 32 + r32] = ss;
    __syncthreads();
    const float tot = (ssm[mt * 32 + r32] + ssm[(2 + mt) * 32 + r32]) + (ssm[(4 + mt) * 32 + r32] + ssm[(6 + mt) * 32 + r32]);
    const float rs = rsqrtf(tot * (1.f / MEMW) + EPS);
    const float* gain = p.in[I_MIXG] + POOLW + LRUW + hd * 128;
    bf16_t* mrow = mix + (size_t)(t0 + r32) * MIXW + POOLW + LRUW + hd * 128;
#pragma unroll
    for (int dt = 0; dt < 4; ++dt)
#pragma unroll
        for (int rg = 0; rg < 4; ++rg) { const int c = 32 * dt + 8 * rg + 4 * hh; const f32x4 g = *(const f32x4*)(gain + c);
            uint2 w; w.x = cvtpk(o[dt][4 * rg] * rs * g[0], o[dt][4 * rg + 1] * rs * g[1]); w.y = cvtpk(o[dt][4 * rg + 2] * rs * g[2], o[dt][4 * rg + 3] * rs * g[3]);
            *(uint2*)(mrow + c) = w; }
    __syncthreads();
}


DEVI float bflo(unsigned w) { return __uint_as_float(w << 16); }
DEVI float bfhi(unsigned w) { return __uint_as_float(w & 0xffff0000u); }
DEVI void p2_pool(const P& p, unsigned char* lds, int tile) {
    const int tid = opaque_tid(), wave = __builtin_amdgcn_readfirstlane(tid >> 6), lane = tid & 63, r32 = lane & 31, hh = lane >> 5;
    const int g = wave >> 1, mt = wave & 1, W = 2 << g, t = tile * 64 + mt * 32 + r32, pos = t % SEQ;
    const bf16_t* hb = (const bf16_t*)(p.ws + WS_HB); const bf16_t* wpt = (const bf16_t*)(p.ws + WS_WPT) + (size_t)g * 16384; bf16_t* mix = (bf16_t*)(p.ws + WS_MIX);
    const float invc = 1.f / (float)((pos + 1 < W) ? pos + 1 : W);
    f32x16 acc[4];
#pragma unroll
    for (int nt = 0; nt < 4; ++nt) acc[nt] = zero16();
    const bf16_t* urow = hb + (size_t)t * INW + g * 128 + hh * 8;
#pragma unroll 2
    for (int ks = 0; ks < 8; ++ks) {
        float sm8[8];
#pragma unroll
        for (int j = 0; j < 8; ++j) sm8[j] = 0.f;
        float cur[8];
        for (int tau = 0; tau < W; ++tau) {
            v4u raw = {0u, 0u, 0u, 0u};
            if (pos - tau >= 0) raw = *(const v4u*)(urow - (size_t)tau * INW + ks * 16);
            const float x0 = bflo(raw.x), x1 = bfhi(raw.x), x2 = bflo(raw.y), x3 = bfhi(raw.y), x4 = bflo(raw.z), x5 = bfhi(raw.z), x6 = bflo(raw.w), x7 = bfhi(raw.w);
            if (tau == 0) { cur[0] = x0; cur[1] = x1; cur[2] = x2; cur[3] = x3; cur[4] = x4; cur[5] = x5; cur[6] = x6; cur[7] = x7; }
            sm8[0] += x0; sm8[1] += x1; sm8[2] += x2; sm8[3] += x3; sm8[4] += x4; sm8[5] += x5; sm8[6] += x6; sm8[7] += x7;
        }
        const bf16x8 df = pack8(sm8[0] * invc - cur[0], sm8[1] * invc - cur[1], sm8[2] * invc - cur[2], sm8[3] * invc - cur[3],
                                sm8[4] * invc - cur[4], sm8[5] * invc - cur[5], sm8[6] * invc - cur[6], sm8[7] * invc - cur[7]);
#pragma unroll
        for (int nt = 0; nt < 4; ++nt) { const bf16x8 wf = *(const bf16x8*)(wpt + (size_t)(nt * 32 + r32) * 128 + ks * 16 + hh * 8); acc[nt] = MFMA32(wf, df, acc[nt]); }
    }
    const float* psc = p.in[I_PSCALE] + g * 128; float ss = 0.f;
#pragma unroll
    for (int nt = 0; nt < 4; ++nt)
#pragma unroll
        for (int rg = 0; rg < 4; ++rg) { const f32x4 s4 = *(const f32x4*)(psc + nt * 32 + 8 * rg + 4 * hh);
#pragma unroll
            for (int e = 0; e < 4; ++e) { const float y = acc[nt][4 * rg + e] * s4[e]; acc[nt][4 * rg + e] = y; ss = fmaf(y, y, ss); } }
    ss += xhalf(ss);
    LAS float* ssm = (LAS float*)(LAS unsigned char*)lds;
    if (hh == 0) ssm[wave * 32 + r32] = ss;
    __syncthreads();
    const float tot = (ssm[mt * 32 + r32] + ssm[(2 + mt) * 32 + r32]) + (ssm[(4 + mt) * 32 + r32] + ssm[(6 + mt) * 32 + r32]);
    const float rs = rsqrtf(tot * (1.f / POOLW) + EPS);
    const float* gain = p.in[I_MIXG] + g * 128;
    bf16_t* mrow = mix + (size_t)t * MIXW + g * 128;
#pragma unroll
    for (int nt = 0; nt < 4; ++nt)
#pragma unroll
        for (int rg = 0; rg < 4; ++rg) { const int c = 32 * nt + 8 * rg + 4 * hh; const f32x4 gv = *(const f32x4*)(gain + c);
            uint2 w; w.x = cvtpk(acc[nt][4 * rg] * rs * gv[0], acc[nt][4 * rg + 1] * rs * gv[1]); w.y = cvtpk(acc[nt][4 * rg + 2] * rs * gv[2], acc[nt][4 * rg + 3] * rs * gv[3]);
            *(uint2*)(mrow + c) = w; }
    __syncthreads();
}

DEVI float fast_sigmoid(float v) { return __builtin_amdgcn_rcpf(1.f + __expf(-v)); }
DEVI float one_minus_exp(float x) {
    const float ser = -x * (1.f + x * (0.5f + x * (0.16666667f + x * (0.041666668f + x * 0.0083333338f))));
    const float dir = 1.f - __expf(x);
    return (x > -0.125f) ? ser : dir;
}
typedef __amdgpu_buffer_rsrc_t rsrc_t;
typedef unsigned v2u __attribute__((ext_vector_type(2)));
DEVI rsrc_t mkrsrc(const void* ptr, unsigned bytes) { return __builtin_amdgcn_make_buffer_rsrc((void*)ptr, 0, (int)bytes, 0x00020000); }
DEVI v4u bl128(rsrc_t r, unsigned vo, unsigned so) { return __builtin_amdgcn_raw_buffer_load_b128(r, (int)vo, (int)so, 0); }
DEVI v2u bl64(rsrc_t r, unsigned vo, unsigned so) { return __builtin_amdgcn_raw_buffer_load_b64(r, (int)vo, (int)so, 0); }
DEVI unsigned bl32(rsrc_t r, unsigned vo, unsigned so) { return __builtin_amdgcn_raw_buffer_load_b32(r, (int)vo, (int)so, 0); }
DEVI f32x4 bl128f(rsrc_t r, unsigned vo, unsigned so) { return __builtin_bit_cast(f32x4, bl128(r, vo, so)); }
DEVI float bl32f(rsrc_t r, unsigned vo, unsigned so) { return __uint_as_float(bl32(r, vo, so)); }
DEVI void bs32(rsrc_t r, unsigned vo, unsigned so, unsigned v) { __builtin_amdgcn_raw_buffer_store_b32(v, r, (int)vo, (int)so, 0); }
DEVI void bs64(rsrc_t r, unsigned vo, unsigned so, v2u v) { __builtin_amdgcn_raw_buffer_store_b64(v, r, (int)vo, (int)so, 0); }

DEVI void p2_lru_local(const P& p, int tile) {
    const int tid = opaque_tid(), h = __builtin_amdgcn_readfirstlane(tid >> 6), lane = tid & 63, r32 = lane & 31, hh = lane >> 5;
    const int t0 = tile * 64, pos0 = t0 % SEQ;
    const rsrc_t Rhb = mkrsrc(p.ws + WS_HB, (unsigned)((size_t)M * INW * 2)), Rwa = mkrsrc(p.ws + WS_WAT, 8 * 16384 * 2), Rwx = mkrsrc(p.ws + WS_WXT, 8 * 16384 * 2);
    const rsrc_t Rhc = mkrsrc(p.ws + WS_HC, (unsigned)((size_t)M * LRUW * 4)), Ragg = mkrsrc(p.ws + WS_AGG, 256 * LRUW * 8);
    const rsrc_t Rcw = mkrsrc(p.in[I_CONVW], 4 * LRUW * 4), Rcb = mkrsrc(p.in[I_CONVB], LRUW * 4), Rba = mkrsrc(p.in[I_BA], LRUW * 4), Rbx = mkrsrc(p.in[I_BX], LRUW * 4), Rlam = mkrsrc(p.in[I_LAM], LRUW * 4);
    const unsigned vo8 = (unsigned)hh * 32u;
    const unsigned voB = (unsigned)(r32 * 128 + hh * 8) * 2u;
    const unsigned sch = (unsigned)h * 128u;
    float hcar[4], Acar[4];
#pragma unroll
    for (int nt = 0; nt < 4; ++nt) { hcar[nt] = 0.f; Acar[nt] = 1.f; }
#pragma unroll 1
    for (int mt = 0; mt < 2; ++mt) {
        const int t = t0 + mt * 32 + r32, pos = pos0 + mt * 32 + r32;
        unsigned rofs[4]; float rm[4];
#pragma unroll
        for (int tau = 0; tau < 4; ++tau) { const bool ok = (pos - 3 + tau) >= 0;
            rofs[tau] = (unsigned)((ok ? t - 3 + tau : t) * INW + hh * 8) * 2u; rm[tau] = ok ? 1.f : 0.f; }
        bf16x8 af[8];
#pragma unroll
        for (int ks = 0; ks < 8; ++ks) {
            f32x4 ua = bl128f(Rcb, vo8 + ks * 64, sch * 4u), ub = bl128f(Rcb, vo8 + ks * 64 + 16, sch * 4u);
#pragma unroll
            for (int tau = 0; tau < 4; ++tau) {
                const v4u raw = bl128(Rhb, rofs[tau] + ks * 32, (POOLW + sch) * 2u);
                const f32x4 w0 = bl128f(Rcw, vo8 + ks * 64, (tau * LRUW + sch) * 4u), w1 = bl128f(Rcw, vo8 + ks * 64 + 16, (tau * LRUW + sch) * 4u);
                f32x4 xa = {bflo(raw.x), bfhi(raw.x), bflo(raw.y), bfhi(raw.y)}, xb = {bflo(raw.z), bfhi(raw.z), bflo(raw.w), bfhi(raw.w)};
                ua += (w0 * rm[tau]) * xa; ub += (w1 * rm[tau]) * xb;
            }
            af[ks] = pack8(ua[0], ua[1], ua[2], ua[3], ub[0], ub[1], ub[2], ub[3]);
            if (ks & 1) { asm volatile("" ::: "memory"); __builtin_amdgcn_sched_barrier(0); }
        }
#pragma unroll
        for (int nt = 0; nt < 4; ++nt) {
            asm volatile("" ::: "memory"); __builtin_amdgcn_sched_barrier(0);
            f32x16 ra = zero16(), rx = zero16(), uc = zero16();
            const unsigned sw = (unsigned)(h * 16384 + nt * 4096) * 2u;
#pragma unroll
            for (int ks = 0; ks < 8; ++ks) {
                const bf16x8 wa = __builtin_bit_cast(bf16x8, bl128(Rwa, voB + ks * 32, sw)), wx = __builtin_bit_cast(bf16x8, bl128(Rwx, voB + ks * 32, sw));
                ra = MFMA32(af[ks], wa, ra); rx = MFMA32(af[ks], wx, rx);
            }
#pragma unroll
            for (int q = 0; q < 2; ++q) {
                const int jj = r32 - 16 * q - 8 * hh;
                v4u idw;
                idw.x = (jj == 0) ? 0x00003F80u : ((jj == 1) ? 0x3F800000u : 0u); idw.y = (jj == 2) ? 0x00003F80u : ((jj == 3) ? 0x3F800000u : 0u);
                idw.z = (jj == 4) ? 0x00003F80u : ((jj == 5) ? 0x3F800000u : 0u); idw.w = (jj == 6) ? 0x00003F80u : ((jj == 7) ? 0x3F800000u : 0u);
                uc = MFMA32(af[2 * nt + q], __builtin_bit_cast(bf16x8, idw), uc);
            }
            const unsigned vc = (unsigned)r32 * 4u, sc4 = (sch + nt * 32) * 4u;
            const float bac = bl32f(Rba, vc, sc4), bxc = bl32f(Rbx, vc, sc4), sp8 = -8.f * log1pf(__expf(-bl32f(Rlam, vc, sc4)));
#pragma unroll
            for (int r = 0; r < 16; ++r) {
                const float rr = fast_sigmoid(ra[r] + bac), ii = fast_sigmoid(rx[r] + bxc);
                const float la = rr * sp8, a = __expf(la), mult = __builtin_amdgcn_sqrtf(fmaxf(one_minus_exp(2.f * la), 0.f));
                ra[r] = a; rx[r] = mult * ii * uc[r];
            }
            float hc = hcar[nt], Ac = Acar[nt];
#pragma unroll
            for (int g4 = 0; g4 < 4; ++g4) {
                const int rb = g4 * 4;
                const float a0 = ra[rb], a1 = ra[rb + 1], a2 = ra[rb + 2], a3 = ra[rb + 3];
                const float b0 = rx[rb], b1 = rx[rb + 1], b2 = rx[rb + 2], b3 = rx[rb + 3];
                const float P0 = a0, l0 = b0, P1 = a1 * P0, l1 = fmaf(a1, l0, b1), P2 = a2 * P1, l2 = fmaf(a2, l1, b2), P3 = a3 * P2, l3 = fmaf(a3, l2, b3);
                const float he = fmaf(P3, hc, l3), Ae = P3 * Ac;
                float th = xhalf(he), tA = xhalf(Ae);
                if (hh) { hc = th; Ac = tA; }
                const float h0 = fmaf(P0, hc, l0), h1 = fmaf(P1, hc, l1), h2 = fmaf(P2, hc, l2), h3 = fmaf(P3, hc, l3);
                const float c0 = P0 * Ac, c1 = P1 * Ac, c2 = P2 * Ac, c3 = P3 * Ac;
                rx[rb] = h0; rx[rb + 1] = h1; rx[rb + 2] = h2; rx[rb + 3] = h3;
                ra[rb] = c0; ra[rb + 1] = c1; ra[rb + 2] = c2; ra[rb + 3] = c3;
                th = xhalf(h3); tA = xhalf(c3);
                if (!hh) { hc = th; Ac = tA; }
            }
            hcar[nt] = hc; Acar[nt] = Ac;
            const unsigned vhc = (unsigned)(4 * hh * LRUW + r32) * 4u;
#pragma unroll
            for (int r = 0; r < 16; ++r) bs32(Rhc, vhc, (unsigned)((t0 + mt * 32 + (r & 3) + 8 * (r >> 2)) * LRUW + sch + nt * 32) * 4u, cvtpk(rx[r], ra[r]));
            if (mt == 1 && !hh) { v2u ag = {__float_as_uint(Ac), __float_as_uint(hc)}; bs64(Ragg, (unsigned)r32 * 8u, (unsigned)(tile * LRUW + sch + nt * 32) * 8u, ag); }
        }
    }
}
DEVI void p2_lru_final(const P& p, unsigned char* lds, int tile) {
    const int tid = opaque_tid(), h = __builtin_amdgcn_readfirstlane(tid >> 6), lane = tid & 63;
    const int c = h * 128 + 2 * lane, t0 = tile * 64, j0 = (tile / (SEQ / 64)) * (SEQ / 64);
    const bf16_t* hb = (const bf16_t*)(p.ws + WS_HB); const unsigned* HC = (const unsigned*)(p.ws + WS_HC); const float* agg = (const float*)(p.ws + WS_AGG); bf16_t* mix = (bf16_t*)(p.ws + WS_MIX);
    float h0 = 0.f, h1 = 0.f;
#pragma unroll 8
    for (int j = j0; j < tile; ++j) { const f32x4 ag = *(const f32x4*)(agg + ((size_t)j * LRUW + c) * 2); h0 = fmaf(ag[0], h0, ag[1]); h1 = fmaf(ag[2], h1, ag[3]); }
    float sq[64];
#define LRU_Y(tt) \
        const uint2 hc2 = *(const uint2*)(HC + (size_t)(t0 + (tt)) * LRUW + c); const unsigned gt = *(const unsigned*)(hb + (size_t)(t0 + (tt)) * INW + POOLW + LRUW + c); \
        const float g0 = bflo(gt), g1 = bfhi(gt); \
        const float u0 = 0.7978845608028654f * (g0 + 0.044715f * g0 * g0 * g0), u1 = 0.7978845608028654f * (g1 + 0.044715f * g1 * g1 * g1); \
        const float y0 = g0 / (1.f + __expf(-2.f * u0)) * fmaf(bfhi(hc2.x), h0, bflo(hc2.x)), y1 = g1 / (1.f + __expf(-2.f * u1)) * fmaf(bfhi(hc2.y), h1, bflo(hc2.y));
#pragma unroll
    for (int tt = 0; tt < 64; ++tt) { LRU_Y(tt) sq[tt] = fmaf(y0, y0, y1 * y1); if ((tt & 7) == 7) asm volatile("" ::: "memory"); }
#pragma unroll
    for (int o = 32; o >= 1; o >>= 1) {
        const bool up = (lane & o) != 0;
#pragma unroll
        for (int i = 0; i < o; ++i) { const float send = up ? sq[i] : sq[i + o], keep = up ? sq[i + o] : sq[i]; sq[i] = keep + __shfl_xor(send, o); }
    }
    LAS float* ssm = (LAS float*)(LAS unsigned char*)lds;
    ssm[h * 64 + lane] = sq[0];
    __syncthreads();
    float tot = 0.f;
#pragma unroll
    for (int w = 0; w < 8; ++w) tot += ssm[w * 64 + lane];
    ssm[512 + h * 64 + lane] = rsqrtf(tot * (1.f / LRUW) + EPS);
    __syncthreads();
    const float gn0 = p.in[I_MIXG][POOLW + c], gn1 = p.in[I_MIXG][POOLW + c + 1];
#pragma unroll 8
    for (int tt = 0; tt < 64; ++tt) { const float rs = ssm[512 + h * 64 + tt]; LRU_Y(tt)
        *(unsigned*)(mix + (size_t)(t0 + tt) * MIXW + POOLW + c) = cvtpk(y0 * rs * gn0, y1 * rs * gn1); }
#undef LRU_Y
    __syncthreads();
}


DEVI void p4_route(const P& p, unsigned char* lds, int tile) {
    const int tid = opaque_tid(), wave = __builtin_amdgcn_readfirstlane(tid >> 6), lane = tid & 63, r32 = lane & 31, hh = lane >> 5;
    const int t0 = tile * 64;
    const float* z = p.out; bf16_t* x1b = (bf16_t*)(p.ws + WS_X1B);
    const float* g1 = p.in[I_LN1G]; const float* b1 = p.in[I_LN1B];
    LAS float* st = (LAS float*)(LAS unsigned char*)lds;
    LAS float* red = (LAS float*)((LAS unsigned char*)lds + 1024);
    LAS float* lgs = (LAS float*)((LAS unsigned char*)lds + 1024 + 73728);
    LAS int* hist = (LAS int*)((LAS unsigned char*)lds + 1024 + 73728 + 9728);
    if (tid < 64) hist[tid] = 0;
#pragma unroll 1
    for (int rr = 0; rr < 8; ++rr) {
        const int t = t0 + wave * 8 + rr;
        f32x4 v[8]; float s = 0.f;
#pragma unroll
        for (int j = 0; j < 8; ++j) { v[j] = *(const f32x4*)(z + (size_t)t * D + j * 256 + lane * 4); s += (v[j][0] + v[j][1]) + (v[j][2] + v[j][3]); }
        const float mean = wave_sum(s) * (1.f / D); float s2 = 0.f;
#pragma unroll
        for (int j = 0; j < 8; ++j) { v[j] = v[j] - mean; s2 += (v[j][0] * v[j][0] + v[j][1] * v[j][1]) + (v[j][2] * v[j][2] + v[j][3] * v[j][3]); }
        const float rstd = rsqrtf(wave_sum(s2) * (1.f / D) + EPS);
        if (lane == 0) { st[(wave * 8 + rr) * 2] = mean; st[(wave * 8 + rr) * 2 + 1] = rstd; }
#pragma unroll
        for (int j = 0; j < 8; ++j) { const f32x4 g = *(const f32x4*)(g1 + j * 256 + lane * 4), b = *(const f32x4*)(b1 + j * 256 + lane * 4);
            const f32x4 o = v[j] * rstd * g + b; uint2 w; w.x = cvtpk(o[0], o[1]); w.y = cvtpk(o[2], o[3]);
            *(uint2*)(x1b + (size_t)t * D + j * 256 + lane * 4) = w; }
    }
    __syncthreads();
    const bf16_t* wrh = (const bf16_t*)(p.ws + WS_WRH); const bf16_t* wrl = (const bf16_t*)(p.ws + WS_WRL);
    f32x16 acc[2][2];
#pragma unroll
    for (int a = 0; a < 2; ++a)
#pragma unroll
        for (int b = 0; b < 2; ++b) acc[a][b] = zero16();
    float mu[2], rs[2];
#pragma unroll
    for (int tt = 0; tt < 2; ++tt) { mu[tt] = st[(tt * 32 + r32) * 2]; rs[tt] = st[(tt * 32 + r32) * 2 + 1]; }
#pragma unroll 2
    for (int ks = 0; ks < 16; ++ks) {
        const int k0 = wave * 256 + ks * 16 + hh * 8;
        const f32x4 ga = *(const f32x4*)(g1 + k0), gb = *(const f32x4*)(g1 + k0 + 4), ba = *(const f32x4*)(b1 + k0), bb = *(const f32x4*)(b1 + k0 + 4);
        bf16x8 xh[2], xl[2];
#pragma unroll
        for (int tt = 0; tt < 2; ++tt) {
            const float* zr = z + (size_t)(t0 + tt * 32 + r32) * D + k0;
            const f32x4 za = *(const f32x4*)zr, zb = *(const f32x4*)(zr + 4);
            const f32x4 xa = (za - mu[tt]) * rs[tt] * ga + ba, xb = (zb - mu[tt]) * rs[tt] * gb + bb;
            v4u hw; hw.x = cvtpk(xa[0], xa[1]); hw.y = cvtpk(xa[2], xa[3]); hw.z = cvtpk(xb[0], xb[1]); hw.w = cvtpk(xb[2], xb[3]);
            v4u lw; lw.x = cvtpk(xa[0] - bflo(hw.x), xa[1] - bfhi(hw.x)); lw.y = cvtpk(xa[2] - bflo(hw.y), xa[3] - bfhi(hw.y));
            lw.z = cvtpk(xb[0] - bflo(hw.z), xb[1] - bfhi(hw.z)); lw.w = cvtpk(xb[2] - bflo(hw.w), xb[3] - bfhi(hw.w));
            xh[tt] = __builtin_bit_cast(bf16x8, hw); xl[tt] = __builtin_bit_cast(bf16x8, lw);
        }
#pragma unroll
        for (int nt = 0; nt < 2; ++nt) {
            const bf16x8 wh = *(const bf16x8*)(wrh + (size_t)(nt * 32 + r32) * D + k0), wl = *(const bf16x8*)(wrl + (size_t)(nt * 32 + r32) * D + k0);
#pragma unroll
            for (int tt = 0; tt < 2; ++tt) { acc[nt][tt] = MFMA32(wh, xh[tt], acc[nt][tt]); acc[nt][tt] = MFMA32(wh, xl[tt], acc[nt][tt]); acc[nt][tt] = MFMA32(wl, xh[tt], acc[nt][tt]); }
        }
    }
#pragma unroll
    for (int tt = 0; tt < 2; ++tt) {
#pragma unroll
        for (int r = 0; r < 16; ++r) { const int n = (r & 3) + 8 * (r >> 2) + 4 * hh; red[(wave * 36 + n) * 64 + tt * 32 + r32] = acc[0][tt][r]; }
        if (hh == 0) {
#pragma unroll
            for (int r = 0; r < 4; ++r) red[(wave * 36 + 32 + r) * 64 + tt * 32 + r32] = acc[1][tt][r]; }
    }
    __syncthreads();
    {
        const int tok = tid & 63, part = tid >> 6;
#pragma unroll
        for (int q = 0; q < 5; ++q) { const int n = part * 5 + q; if (n < 36) { float sacc = 0.f;
#pragma unroll
                for (int w = 0; w < 8; ++w) sacc += red[(w * 36 + n) * 64 + tok];
                lgs[tok * 37 + n] = sacc; } }
    }
    __syncthreads();
    int ea = 0, eb = 0, ra_ = 0, rb_ = 0; float w0 = 0.f, w1 = 0.f;
    if (tid < 64) {
        const float* bg = p.in[I_BGROUP]; const float* bfine = p.in[I_BFINE];
        float lg[4];
#pragma unroll
        for (int o = 0; o < 4; ++o) lg[o] = lgs[tid * 37 + 32 + o] + bg[o];
        int gi = 0; float gm = lg[0];
#pragma unroll
        for (int o = 1; o < 4; ++o) if (lg[o] > gm) { gm = lg[o]; gi = o; }
        float ge = 0.f;
#pragma unroll
        for (int o = 0; o < 4; ++o) ge += __expf(lg[o] - gm);
        const float gp = 1.f / ge;
        float fs[8];
#pragma unroll
        for (int j = 0; j < 8; ++j) fs[j] = lgs[tid * 37 + gi * 8 + j] + bfine[gi * 8 + j];
        int i0 = 0; float l0 = fs[0];
#pragma unroll
        for (int j = 1; j < 8; ++j) if (fs[j] > l0) { l0 = fs[j]; i0 = j; }
        int i1 = -1; float l1 = -3.0e38f;
#pragma unroll
        for (int j = 0; j < 8; ++j) if (j != i0 && fs[j] > l1) { l1 = fs[j]; i1 = j; }
        const float e1 = __expf(l1 - l0); w0 = gp / (1.f + e1); w1 = gp * e1 / (1.f + e1);
        ea = gi * 8 + i0; eb = gi * 8 + i1;
        ra_ = atomicAdd((int*)&hist[ea], 1); rb_ = atomicAdd((int*)&hist[eb], 1);
    }
    __syncthreads();
    if (tid < 32) { int* cnt = (int*)(p.ws + WS_CTL) + CW_CNT; const int c = hist[tid]; hist[32 + tid] = c ? atomicAdd(&cnt[tid], c) : 0; }
    __syncthreads();
    if (tid < 64) {
        int* asg_e = (int*)(p.ws + WS_ASG_E); int* asg_s = (int*)(p.ws + WS_ASG_S); float* asg_w = (float*)(p.ws + WS_ASG_W);
        const int t = t0 + tid;
        asg_e[2 * t] = ea; asg_e[2 * t + 1] = eb; asg_s[2 * t] = hist[32 + ea] + ra_; asg_s[2 * t + 1] = hist[32 + eb] + rb_; asg_w[2 * t] = w0; asg_w[2 * t + 1] = w1;
    }
    __syncthreads();
}

template <bool DUAL, class AL, class BL, class BL2, class EP>
DEVI void sgemm_tile(int m0, int n0, int K, AL aload, BL bload, BL2 bload2, EP epi, float* sm) {
    float* As = sm;
    float* Bs = sm + 16 * 132;
    float* Bs2 = Bs + 16 * 68;
    const int tid = opaque_tid(), ty = tid >> 4, tx = tid & 15;
    float acc[4][4], acc2[4][4];
#pragma unroll
    for (int i = 0; i < 4; ++i)
#pragma unroll
        for (int j = 0; j < 4; ++j) { acc[i][j] = 0.f; acc2[i][j] = 0.f; }
    for (int k0 = 0; k0 < K; k0 += 16) {
#pragma unroll
        for (int i = 0; i < 4; ++i) { const int e = tid + i * NT, r = e >> 4, kk = e & 15; As[kk * 132 + r] = aload(m0 + r, k0 + kk); }
#pragma unroll
        for (int i = 0; i < 2; ++i) { const int e = tid + i * NT, kk = e >> 6, n = e & 63; Bs[kk * 68 + n] = bload(k0 + kk, n0 + n); if (DUAL) Bs2[kk * 68 + n] = bload2(k0 + kk, n0 + n); }
        __syncthreads();
#pragma unroll
        for (int kk = 0; kk < 16; ++kk) {
            const float4 a = *(const float4*)(As + kk * 132 + ty * 4);
            const float4 b = *(const float4*)(Bs + kk * 68 + tx * 4);
            const float av[4] = {a.x, a.y, a.z, a.w}, bv[4] = {b.x, b.y, b.z, b.w};
#pragma unroll
            for (int i = 0; i < 4; ++i)
#pragma unroll
                for (int j = 0; j < 4; ++j) acc[i][j] = fmaf(av[i], bv[j], acc[i][j]);
            if (DUAL) {
                const float4 b2 = *(const float4*)(Bs2 + kk * 68 + tx * 4);
                const float bw[4] = {b2.x, b2.y, b2.z, b2.w};
#pragma unroll
                for (int i = 0; i < 4; ++i)
#pragma unroll
                    for (int j = 0; j < 4; ++j) acc2[i][j] = fmaf(av[i], bw[j], acc2[i][j]);
            }
        }
        __syncthreads();
    }
#pragma unroll
    for (int i = 0; i < 4; ++i)
#pragma unroll
        for (int j = 0; j < 4; ++j) epi(m0 + ty * 4 + i, n0 + tx * 4 + j, acc[i][j], acc2[i][j]);
}

DEVI void s1_inproj(const P& p, float* sm) {
    const float* x = p.in[I_X]; const float* w = p.in[I_WIN]; bf16_t* hb = (bf16_t*)(p.ws + WS_HB);
#if NAIVE_INPROJ
    const int ntn = INW / 64, nt = (M / 128) * ntn;
    for (int it = blockIdx.x; it < nt; it += gridDim.x) {
        const int m0 = (it / ntn) * 128, n0 = (it % ntn) * 64;
        auto al = [&](int r, int k) { return x[(size_t)r * D + k]; };
        auto bl = [&](int k, int n) { return w[(size_t)k * INW + n]; };
        auto ep = [&](int r, int n, float v, float) { hb[(size_t)r * INW + n] = f2bf(v); };
        sgemm_tile<false>(m0, n0, D, al, bl, bl, ep, sm);
    }
#else
    (void)x; (void)w; (void)hb;
#endif
    const float* mem = p.in[I_MEM]; const float* wkv = p.in[I_WKV]; bf16_t* kb = (bf16_t*)(p.ws + WS_KB); bf16_t* vt = (bf16_t*)(p.ws + WS_VT);
    const int nt2 = NAIVE_KV ? (BATCH * MEMLEN / 128) * (2 * MEMW / 64) : 0;
    for (int it = blockIdx.x; it < nt2; it += gridDim.x) {
        const int m0 = (it / 16) * 128, n0 = (it % 16) * 64;
        auto al = [&](int r, int k) { return mem[(size_t)r * D + k]; };
        auto bl = [&](int k, int n) { return wkv[(size_t)k * (2 * MEMW) + n]; };
        auto ep = [&](int r, int n, float v, float) {
            const int b = r / MEMLEN, key = r % MEMLEN;
            if (n < MEMW) { const int hd = n >> 7, d = n & 127; kb[((size_t)(b * 4 + hd) * MEMLEN + key) * 128 + d] = f2bf(v); }
            else { const int n2 = n - MEMW, hd = n2 >> 7, d = n2 & 127; vt[((size_t)(b * 4 + hd) * 128 + d) * MEMLEN + permkey(key)] = f2bf(v); }
        };
        sgemm_tile<false>(m0, n0, D, al, bl, bl, ep, sm);
    }
}
DEVI void s2a_pool(const P& p, float* sm) {
    const bf16_t* hb = (const bf16_t*)(p.ws + WS_HB); float* ypool = (float*)(p.ws + WS_YPOOL);
    const float* wp = p.in[I_WPOOL]; const float* ps = p.in[I_PSCALE];
    const int tid = opaque_tid(), g = tid >> 7, c = tid & 127, w = 2 << g;
    for (int t = blockIdx.x; t < M; t += gridDim.x) {
        const int pos = t % SEQ;
        float s = 0.f;
        for (int j = 0; j < w; ++j) if (pos - j >= 0) s += bf2f(hb[(size_t)(t - j) * INW + g * 128 + c]);
        const float cntf = (float)((pos + 1 < w) ? pos + 1 : w);
        sm[tid] = s / cntf - bf2f(hb[(size_t)t * INW + g * 128 + c]);
        __syncthreads();
        float y = 0.f;
        for (int cc = 0; cc < 128; ++cc) y = fmaf(sm[g * 128 + cc], wp[((size_t)g * 128 + cc) * 128 + c], y);
        ypool[(size_t)t * POOLW + g * 128 + c] = y * ps[g * 128 + c];
        __syncthreads();
    }
}
DEVI float sigmoidf_(float v) { return 1.f / (1.f + __expf(-v)); }
DEVI void s2b_lru(const P& p, float* sm) {
    const bf16_t* hb = (const bf16_t*)(p.ws + WS_HB); float* aS = (float*)(p.ws + WS_AS); float* bS = (float*)(p.ws + WS_BS);
    const float* cw = p.in[I_CONVW]; const float* cb = p.in[I_CONVB]; const float* wa = p.in[I_WA]; const float* ba = p.in[I_BA];
    const float* wx = p.in[I_WX]; const float* bx = p.in[I_BX]; const float* lam = p.in[I_LAM];
    const int tid = opaque_tid();
    for (int it = blockIdx.x; it < M / 8; it += gridDim.x) {
        const int t0 = it * 8;
#pragma unroll
        for (int q = 0; q < 2; ++q) { const int c = tid + q * NT;
            for (int tt = 0; tt < 8; ++tt) { const int t = t0 + tt, pos = t % SEQ; float u = cb[c];
#pragma unroll
                for (int j = 0; j < 4; ++j) if (pos - 3 + j >= 0) u = fmaf(cw[j * LRUW + c], bf2f(hb[(size_t)(t - 3 + j) * INW + POOLW + c]), u);
                sm[tt * LRUW + c] = u; } }
        __syncthreads();
#pragma unroll
        for (int q = 0; q < 2; ++q) { const int n = tid + q * NT, h = n >> 7, nn = n & 127;
            float ra[8], rx[8];
#pragma unroll
            for (int tt = 0; tt < 8; ++tt) { ra[tt] = ba[n]; rx[tt] = bx[n]; }
            for (int c = 0; c < 128; ++c) { const float w1 = wa[((size_t)h * 128 + c) * 128 + nn], w2 = wx[((size_t)h * 128 + c) * 128 + nn];
#pragma unroll
                for (int tt = 0; tt < 8; ++tt) { const float u = sm[tt * LRUW + h * 128 + c]; ra[tt] = fmaf(u, w1, ra[tt]); rx[tt] = fmaf(u, w2, rx[tt]); } }
            const float sp = log1pf(expf(-lam[n]));
#pragma unroll
            for (int tt = 0; tt < 8; ++tt) { const float r = sigmoidf_(ra[tt]), ii = sigmoidf_(rx[tt]);
                const float la = -8.f * r * sp, a = expf(la), mult = sqrtf(fmaxf(-expm1f(2.f * la), 0.f));
                aS[(size_t)(t0 + tt) * LRUW + n] = a; bS[(size_t)(t0 + tt) * LRUW + n] = mult * ii * sm[tt * LRUW + n]; } }
        __syncthreads();
    }
}
DEVI float gelu_tanh(float v) { const float u = 0.7978845608028654f * (v + 0.044715f * v * v * v); return 0.5f * v * (1.f + tanhf(u)); }
DEVI void s2c_scan(const P& p, float*) {
    const bf16_t* hb = (const bf16_t*)(p.ws + WS_HB); const float* aS = (const float*)(p.ws + WS_AS); const float* bS = (const float*)(p.ws + WS_BS); float* ylru = (float*)(p.ws + WS_YLRU);
    const int idx = blockIdx.x * NT + threadIdx.x;
    if (idx >= BATCH * LRUW) return;
    const int b = idx / LRUW, c = idx % LRUW; float h = 0.f;
    for (int s0 = 0; s0 < SEQ; s0 += 8) {
        float a[8], bb[8], g[8];
#pragma unroll
        for (int j = 0; j < 8; ++j) { const size_t t = (size_t)b * SEQ + s0 + j; a[j] = aS[t * LRUW + c]; bb[j] = bS[t * LRUW + c]; g[j] = bf2f(hb[t * INW + POOLW + LRUW + c]); }
#pragma unroll
        for (int j = 0; j < 8; ++j) { h = fmaf(a[j], h, bb[j]); ylru[((size_t)b * SEQ + s0 + j) * LRUW + c] = gelu_tanh(g[j]) * h; }
    }
}
DEVI void s2d_attn(const P& p, float* sm) {
    const bf16_t* hb = (const bf16_t*)(p.ws + WS_HB); const bf16_t* kb = (const bf16_t*)(p.ws + WS_KB); const bf16_t* vt = (const bf16_t*)(p.ws + WS_VT); float* ymem = (float*)(p.ws + WS_YMEM);
    const int tid = opaque_tid(), wv = tid >> 6, lane = tid & 63;
    float* qs = sm + wv * 384; float* ps = qs + 128;
    for (int it = blockIdx.x; it < M / 2; it += gridDim.x) {
        const int t = it * 2 + (wv >> 2), hd = wv & 3, b = t / SEQ;
        qs[lane] = bf2f(hb[(size_t)t * INW + POOLW + 2 * LRUW + hd * 128 + lane]); qs[lane + 64] = bf2f(hb[(size_t)t * INW + POOLW + 2 * LRUW + hd * 128 + lane + 64]);
        __syncthreads();
        float sc[4];
#pragma unroll
        for (int j = 0; j < 4; ++j) { const int key = lane + 64 * j; const bf16_t* kr = kb + ((size_t)(b * 4 + hd) * MEMLEN + key) * 128; float s = 0.f;
            for (int d = 0; d < 128; ++d) s = fmaf(qs[d], bf2f(kr[d]), s);
            sc[j] = s * 0.08838834764831845f; }
        const float mx = wave_max(fmaxf(fmaxf(sc[0], sc[1]), fmaxf(sc[2], sc[3])));
        float e[4], es = 0.f;
#pragma unroll
        for (int j = 0; j < 4; ++j) { e[j] = __expf(sc[j] - mx); es += e[j]; }
        const float inv = 1.f / wave_sum(es);
#pragma unroll
        for (int j = 0; j < 4; ++j) ps[lane + 64 * j] = e[j] * inv;
        __syncthreads();
#pragma unroll
        for (int q = 0; q < 2; ++q) { const int d = lane + 64 * q; const bf16_t* vr = vt + ((size_t)(b * 4 + hd) * 128 + d) * MEMLEN; float o = 0.f;
            for (int key = 0; key < MEMLEN; ++key) o = fmaf(ps[key], bf2f(vr[permkey(key)]), o);
            ymem[(size_t)t * MEMW + hd * 128 + d] = o; }
        __syncthreads();
    }
}
template <bool DO_POOL, bool DO_LRU, bool DO_MEM> DEVI void s2e_norm(const P& p, float* sm) {
    const float* ypool = (const float*)(p.ws + WS_YPOOL); const float* ylru = (const float*)(p.ws + WS_YLRU); const float* ymem = (const float*)(p.ws + WS_YMEM);
    const float* g = p.in[I_MIXG]; bf16_t* mix = (bf16_t*)(p.ws + WS_MIX);
    const int tid = opaque_tid(), wv = tid >> 6, lane = tid & 63;
    for (int t = blockIdx.x; t < M; t += gridDim.x) {
        const float a = ypool[(size_t)t * POOLW + tid], b0 = ylru[(size_t)t * LRUW + tid], b1 = ylru[(size_t)t * LRUW + tid + NT], c = ymem[(size_t)t * MEMW + tid];
        const float s0 = wave_sum(a * a), s1 = wave_sum(b0 * b0 + b1 * b1), s2 = wave_sum(c * c);
        if (lane == 0) { sm[wv] = s0; sm[8 + wv] = s1; sm[16 + wv] = s2; }
        __syncthreads();
        float t0 = 0.f, t1 = 0.f, t2 = 0.f;
#pragma unroll
        for (int i = 0; i < 8; ++i) { t0 += sm[i]; t1 += sm[8 + i]; t2 += sm[16 + i]; }
        const float r0 = rsqrtf(t0 / POOLW + EPS), r1 = rsqrtf(t1 / LRUW + EPS), r2 = rsqrtf(t2 / MEMW + EPS);
        bf16_t* mr = mix + (size_t)t * MIXW;
        if (DO_POOL) mr[tid] = f2bf(a * r0 * g[tid]);
        if (DO_LRU) { mr[POOLW + tid] = f2bf(b0 * r1 * g[POOLW + tid]); mr[POOLW + NT + tid] = f2bf(b1 * r1 * g[POOLW + NT + tid]); }
        if (DO_MEM) mr[POOLW + LRUW + tid] = f2bf(c * r2 * g[POOLW + LRUW + tid]);
        __syncthreads();
    }
}
DEVI void s3_outproj(const P& p, float* sm) {
    const float* x = p.in[I_X]; const float* w = p.in[I_WOUT]; const bf16_t* mix = (const bf16_t*)(p.ws + WS_MIX); float* z = p.out;
    const int ntn = D / 64, nt = (M / 128) * ntn;
    for (int it = blockIdx.x; it < nt; it += gridDim.x) {
        const int m0 = (it / ntn) * 128, n0 = (it % ntn) * 64;
        auto al = [&](int r, int k) { return bf2f(mix[(size_t)r * MIXW + k]); };
        auto bl = [&](int k, int n) { return w[(size_t)k * D + n]; };
        auto ep = [&](int r, int n, float v, float) { z[(size_t)r * D + n] = fmaf(ALPHA, x[(size_t)r * D + n], v); };
        sgemm_tile<false>(m0, n0, MIXW, al, bl, bl, ep, sm);
    }
}
DEVI void s4a_route(const P& p, float*) {
    const float* z = p.out; bf16_t* x1b = (bf16_t*)(p.ws + WS_X1B);
    const float* g1 = p.in[I_LN1G]; const float* b1 = p.in[I_LN1B]; const float* wg = p.in[I_WGROUP]; const float* bg = p.in[I_BGROUP]; const float* wf = p.in[I_WFINE]; const float* bfine = p.in[I_BFINE];
    int* cnt = (int*)(p.ws + WS_CTL) + CW_CNT; int* asg_e = (int*)(p.ws + WS_ASG_E); int* asg_s = (int*)(p.ws + WS_ASG_S); float* asg_w = (float*)(p.ws + WS_ASG_W);
    const int tid = opaque_tid(), wv = tid >> 6, lane = tid & 63;
    for (int t = blockIdx.x * 8 + wv; t < M; t += gridDim.x * 8) {
        float v[32]; float s = 0.f;
#pragma unroll
        for (int j = 0; j < 8; ++j) { const float4 q = *(const float4*)(z + (size_t)t * D + j * 256 + lane * 4); v[4 * j] = q.x; v[4 * j + 1] = q.y; v[4 * j + 2] = q.z; v[4 * j + 3] = q.w; s += (q.x + q.y) + (q.z + q.w); }
        const float mean = wave_sum(s) * (1.f / D); float s2 = 0.f;
#pragma unroll
        for (int i = 0; i < 32; ++i) { v[i] -= mean; s2 = fmaf(v[i], v[i], s2); }
        const float rstd = rsqrtf(wave_sum(s2) * (1.f / D) + EPS);
#pragma unroll
        for (int j = 0; j < 8; ++j) {
#pragma unroll
            for (int i = 0; i < 4; ++i) { const int k = j * 256 + lane * 4 + i; v[4 * j + i] = v[4 * j + i] * rstd * g1[k] + b1[k]; }
            ushort4 o; o.x = f2bf(v[4 * j]); o.y = f2bf(v[4 * j + 1]); o.z = f2bf(v[4 * j + 2]); o.w = f2bf(v[4 * j + 3]);
            *(ushort4*)(x1b + (size_t)t * D + j * 256 + lane * 4) = o; }
        float lg[4], lf[32];
#pragma unroll
        for (int o = 0; o < 4; ++o) lg[o] = 0.f;
#pragma unroll
        for (int o = 0; o < 32; ++o) lf[o] = 0.f;
#pragma unroll
        for (int j = 0; j < 8; ++j) {
#pragma unroll
            for (int i = 0; i < 4; ++i) { const int k = j * 256 + lane * 4 + i; const float xv = v[4 * j + i];
                const float4 g4 = *(const float4*)(wg + (size_t)k * NG);
                lg[0] = fmaf(xv, g4.x, lg[0]); lg[1] = fmaf(xv, g4.y, lg[1]); lg[2] = fmaf(xv, g4.z, lg[2]); lg[3] = fmaf(xv, g4.w, lg[3]);
#pragma unroll
                for (int q = 0; q < 8; ++q) { const float4 f4 = *(const float4*)(wf + (size_t)k * NE + 4 * q);
                    lf[4 * q] = fmaf(xv, f4.x, lf[4 * q]); lf[4 * q + 1] = fmaf(xv, f4.y, lf[4 * q + 1]); lf[4 * q + 2] = fmaf(xv, f4.z, lf[4 * q + 2]); lf[4 * q + 3] = fmaf(xv, f4.w, lf[4 * q + 3]); } }
            asm volatile("" ::: "memory");
        }
#pragma unroll
        for (int o = 0; o < 4; ++o) lg[o] = wave_sum(lg[o]) + bg[o];
#pragma unroll
        for (int o = 0; o < 32; ++o) lf[o] = wave_sum(lf[o]);
        int gi = 0; float gm = lg[0];
#pragma unroll
        for (int o = 1; o < 4; ++o) if (lg[o] > gm) { gm = lg[o]; gi = o; }
        float ge = 0.f;
#pragma unroll
        for (int o = 0; o < 4; ++o) ge += __expf(lg[o] - gm);
        const float gp = 1.f / ge;
        float fs[8];
#pragma unroll
        for (int j = 0; j < 8; ++j) { float q = lf[j];
#pragma unroll
            for (int o = 1; o < 4; ++o) q = (gi == o) ? lf[o * 8 + j] : q;
            fs[j] = q + bfine[gi * 8 + j]; }
        int i0 = 0; float l0 = fs[0];
#pragma unroll
        for (int j = 1; j < 8; ++j) if (fs[j] > l0) { l0 = fs[j]; i0 = j; }
        int i1 = -1; float l1 = -3.0e38f;
#pragma unroll
        for (int j = 0; j < 8; ++j) if (j != i0 && fs[j] > l1) { l1 = fs[j]; i1 = j; }
        const float e1 = __expf(l1 - l0), w0 = gp / (1.f + e1), w1 = gp * e1 / (1.f + e1);
        if (lane == 0) {
            const int ea = gi * 8 + i0, eb = gi * 8 + i1;
            const int sa = atomicAdd(&cnt[ea], 1), sb = atomicAdd(&cnt[eb], 1);
            asg_e[2 * t] = ea; asg_e[2 * t + 1] = eb; asg_s[2 * t] = sa; asg_s[2 * t + 1] = sb; asg_w[2 * t] = w0; asg_w[2 * t + 1] = w1;
        }
    }
}
DEVI void load_offs(const P& p, int* offs) {
    const int* cnt = (const int*)(p.ws + WS_CTL) + CW_CNT;
    if (threadIdx.x == 0) { int o = 0; for (int e = 0; e < NE; ++e) { offs[e] = o; o += (cnt[e] + 255) / 256 * 256; } offs[NE] = o; }
    __syncthreads();
}
DEVI void s4b_gather(const P& p, float* sm) {
    int* offs = (int*)sm; load_offs(p, offs);
    const bf16_t* x1b = (const bf16_t*)(p.ws + WS_X1B); bf16_t* xg = (bf16_t*)(p.ws + WS_XG);
    const int* asg_e = (const int*)(p.ws + WS_ASG_E); const int* asg_s = (const int*)(p.ws + WS_ASG_S); int* asg_r = (int*)(p.ws + WS_ASG_R);
    const int tid = opaque_tid(), wv = tid >> 6, lane = tid & 63;
    for (int t = blockIdx.x * 8 + wv; t < M; t += gridDim.x * 8) {
        const uint4 a = *(const uint4*)(x1b + (size_t)t * D + lane * 8), b = *(const uint4*)(x1b + (size_t)t * D + 512 + lane * 8),
                    c = *(const uint4*)(x1b + (size_t)t * D + 1024 + lane * 8), d = *(const uint4*)(x1b + (size_t)t * D + 1536 + lane * 8);
#pragma unroll
        for (int k = 0; k < 2; ++k) { const int row = offs[asg_e[2 * t + k]] + asg_s[2 * t + k]; bf16_t* dst = xg + (size_t)row * D;
            *(uint4*)(dst + lane * 8) = a; *(uint4*)(dst + 512 + lane * 8) = b; *(uint4*)(dst + 1024 + lane * 8) = c; *(uint4*)(dst + 1536 + lane * 8) = d;
            if (lane == 0) asg_r[2 * t + k] = row; }
    }
}
DEVI int expert_of_row(const int* offs, int row) { int e = 0; for (int i = 1; i < NE; ++i) if (row >= offs[i]) e = i; return e; }
DEVI float silu_(float v) { return v / (1.f + __expf(-v)); }
DEVI void s5_expert1(const P& p, float* sm) {
    int* offs = (int*)(sm + 8192); load_offs(p, offs);
    const bf16_t* xg = (const bf16_t*)(p.ws + WS_XG); bf16_t* hd = (bf16_t*)(p.ws + WS_HD);
    const int ntn = FF / 64, nt = (offs[NE] / 128) * ntn;
    for (int it = blockIdx.x; it < nt; it += gridDim.x) {
        const int m0 = (it / ntn) * 128, n0 = (it % ntn) * 64, e = expert_of_row(offs, m0);
        const float* wgt = p.in[I_WGATE] + (size_t)e * D * FF; const float* wup = p.in[I_WUP] + (size_t)e * D * FF;
        auto al = [&](int r, int k) { return bf2f(xg[(size_t)r * D + k]); };
        auto bl = [&](int k, int n) { return wgt[(size_t)k * FF + n]; };
        auto bl2 = [&](int k, int n) { return wup[(size_t)k * FF + n]; };
        auto ep = [&](int r, int n, float g, float u) { hd[(size_t)r * FF + n] = f2bf(silu_(g) * u); };
        sgemm_tile<true>(m0, n0, D, al, bl, bl2, ep, sm);
    }
}
DEVI void s6_expert2(const P& p, float* sm) {
    int* offs = (int*)(sm + 8192); load_offs(p, offs);
    const bf16_t* hd = (const bf16_t*)(p.ws + WS_HD); bf16_t* yb = (bf16_t*)(p.ws + WS_YB);
    const int ntn = D / 64, nt = (offs[NE] / 128) * ntn;
    for (int it = blockIdx.x; it < nt; it += gridDim.x) {
        const int m0 = (it / ntn) * 128, n0 = (it % ntn) * 64, e = expert_of_row(offs, m0);
        const float* wd = p.in[I_WDOWN] + (size_t)e * FF * D;
        auto al = [&](int r, int k) { return bf2f(hd[(size_t)r * FF + k]); };
        auto bl = [&](int k, int n) { return wd[(size_t)k * D + n]; };
        auto ep = [&](int r, int n, float v, float) { yb[(size_t)r * D + n] = f2bf(v); };
        sgemm_tile<false>(m0, n0, FF, al, bl, bl, ep, sm);
    }
}
DEVI void s7_final(const P& p, float*) {
    const bf16_t* x1b = (const bf16_t*)(p.ws + WS_X1B); const bf16_t* yb = (const bf16_t*)(p.ws + WS_YB);
    const int* asg_r = (const int*)(p.ws + WS_ASG_R); const float* asg_w = (const float*)(p.ws + WS_ASG_W);
    const float* g2 = p.in[I_LN2G]; const float* b2 = p.in[I_LN2B]; float* out = p.out;
    const int tid = opaque_tid(), wv = tid >> 6, lane = tid & 63;
    for (int t = blockIdx.x * 8 + wv; t < M; t += gridDim.x * 8) {
        const int r0 = asg_r[2 * t], r1 = asg_r[2 * t + 1]; const float w0 = asg_w[2 * t], w1 = asg_w[2 * t + 1];
        float v[32]; float s = 0.f;
#pragma unroll
        for (int j = 0; j < 8; ++j) { const int k = j * 256 + lane * 4;
            const ushort4 a = *(const ushort4*)(x1b + (size_t)t * D + k), y0 = *(const ushort4*)(yb + (size_t)r0 * D + k), y1 = *(const ushort4*)(yb + (size_t)r1 * D + k);
            v[4 * j] = ALPHA * bf2f(a.x) + w0 * bf2f(y0.x) + w1 * bf2f(y1.x); v[4 * j + 1] = ALPHA * bf2f(a.y) + w0 * bf2f(y0.y) + w1 * bf2f(y1.y);
            v[4 * j + 2] = ALPHA * bf2f(a.z) + w0 * bf2f(y0.z) + w1 * bf2f(y1.z); v[4 * j + 3] = ALPHA * bf2f(a.w) + w0 * bf2f(y0.w) + w1 * bf2f(y1.w);
            s += (v[4 * j] + v[4 * j + 1]) + (v[4 * j + 2] + v[4 * j + 3]); }
        const float mean = wave_sum(s) * (1.f / D); float s2 = 0.f;
#pragma unroll
        for (int i = 0; i < 32; ++i) { v[i] -= mean; s2 = fmaf(v[i], v[i], s2); }
        const float rstd = rsqrtf(wave_sum(s2) * (1.f / D) + EPS);
#pragma unroll
        for (int j = 0; j < 8; ++j) { const int k = j * 256 + lane * 4; const float4 g = *(const float4*)(g2 + k), b = *(const float4*)(b2 + k);
            float4 o; o.x = v[4 * j] * rstd * g.x + b.x; o.y = v[4 * j + 1] * rstd * g.y + b.y; o.z = v[4 * j + 2] * rstd * g.z + b.z; o.w = v[4 * j + 3] * rstd * g.w + b.w;
            *(float4*)(out + (size_t)t * D + k) = o; }
    }
}

constexpr int NSTAGE = 12;
template <int S> DEVI void run_stage(const P& p, float* sm) {
    if (S == 0) s1_inproj(p, sm);
    if (S == 1) s2a_pool(p, sm);
    if (S == 2) s2b_lru(p, sm);
    if (S == 3) s2c_scan(p, sm);
    if (S == 4) s2d_attn(p, sm);
    if (S == 5) s2e_norm<true, true, false>(p, sm);
    if (S == 6) s3_outproj(p, sm);
    if (S == 7) s4a_route(p, sm);
    if (S == 8) s4b_gather(p, sm);
    if (S == 9) s5_expert1(p, sm);
    if (S == 10) s6_expert2(p, sm);
    if (S == 11) s7_final(p, sm);
}

constexpr int LDS_BYTES = 144 * 1024;
__global__ void __launch_bounds__(NT, 2) mega_fwd(P p) {
    extern __shared__ __attribute__((aligned(16))) unsigned char lds[];
    float* sm = (float*)lds;
    volatile LAS unsigned* bst = (volatile LAS unsigned*)((LAS unsigned char*)lds + LDS_BYTES - 64);
    if (threadIdx.x < 2) bst[threadIdx.x] = 0u;
    __syncthreads();
    const XcdBarrier bar = xcd_barrier_post((unsigned*)(p.ws + WS_CTL) + CW_BAR, bst);
    p0_prologue(p, lds); __syncthreads(); p0_kv(p, lds); run_stage<0>(p, sm); xcd_barrier(bar);
    p1_inproj(p, lds); xcd_barrier(bar);
    for (int tile = blockIdx.x; tile < M / 64; tile += gridDim.x) { p2_lru_local(p, tile); p2_pool(p, lds, tile); p2_attn(p, lds, tile); }
    xcd_barrier(bar);
    for (int tile = blockIdx.x; tile < M / 64; tile += gridDim.x) p2_lru_final(p, lds, tile);
    xcd_barrier(bar);
    p3_outproj(p, lds); xcd_barrier(bar);
    for (int tile = blockIdx.x; tile < M / 64; tile += gridDim.x) p4_route(p, lds, tile);
    xcd_barrier(bar);
    run_stage<8>(p, sm); xcd_barrier(bar);
    p5_expert1(p, lds); xcd_barrier(bar);
    p6_expert2(p, lds); xcd_barrier(bar);
    run_stage<11>(p, sm);
}
template <int S> __global__ void __launch_bounds__(NT, 2) stage_kernel(P p) {
    extern __shared__ __attribute__((aligned(16))) unsigned char lds[];
    run_stage<S>(p, (float*)lds);
}

extern "C" void kernel_launch(void* const* d_in, const int* in_sizes, int n_in, void* d_out, int out_size, void* d_ws, size_t ws_size, hipStream_t stream) {
    static int grid = 0;
    if (grid == 0) {
        if (n_in != 26 || out_size != M * D || ws_size < WS_END) { fprintf(stderr, "kernel_launch: unexpected shapes: n_in %d out %d ws %zu (need %zu)\n", n_in, out_size, ws_size, (size_t)WS_END); grid = -1; return; }
        int dev = 0, cus = 0, per_cu = 0;
        (void)hipGetDevice(&dev); (void)hipDeviceGetAttribute(&cus, hipDeviceAttributeMultiprocessorCount, dev);
        (void)hipFuncSetAttribute((const void*)mega_fwd, hipFuncAttributeMaxDynamicSharedMemorySize, LDS_BYTES);
        (void)hipOccupancyMaxActiveBlocksPerMultiprocessor(&per_cu, (const void*)mega_fwd, NT, LDS_BYTES);
        if (per_cu < 1) { fprintf(stderr, "kernel_launch: occupancy query says %d blocks per CU\n", per_cu); per_cu = 1; }
        grid = cus;
        fprintf(stderr, "kernel_launch: cus %d per_cu %d grid %d ws %zu\n", cus, per_cu, grid, ws_size);
    }
    if (grid < 0) return;
    (void)hipMemsetAsync((char*)d_ws + WS_CTL, 0, 1 * MiB, stream);
    P p{};
    for (int i = 0; i < 26; ++i) p.in[i] = (const float*)d_in[i];
    p.out = (float*)d_out; p.ws = (unsigned char*)d_ws;
#if ONE_LAUNCH
    void* args[] = {&p};
    hipError_t e = hipLaunchCooperativeKernel((const void*)mega_fwd, dim3(grid), dim3(NT), args, LDS_BYTES, stream);
    if (e != hipSuccess) fprintf(stderr, "cooperative launch failed: %s (grid %d)\n", hipGetErrorString(e), grid);
#else
    const int g2 = grid * 1;
#define LAUNCH(S) do { hipFuncSetAttribute((const void*)stage_kernel<S>, hipFuncAttributeMaxDynamicSharedMemorySize, LDS_BYTES); hipLaunchKernelGGL(stage_kernel<S>, dim3(g2), dim3(NT), LDS_BYTES, stream, p); } while (0)
    LAUNCH(0); LAUNCH(1); LAUNCH(2); LAUNCH(4); LAUNCH(3); LAUNCH(5); LAUNCH(6); LAUNCH(7); LAUNCH(8); LAUNCH(9); LAUNCH(10); LAUNCH(11);
#endif
}
```

```cpp
#include <hip/hip_runtime.h>
#include <hip/hip_cooperative_groups.h>
#include <cstdio>
#include <cstdint>
namespace cg = cooperative_groups;

#define DEVI __device__ __forceinline__
__device__ __forceinline__ int opaque_tid() { int t = threadIdx.x; asm volatile("" : "+v"(t)); return t; }
#ifndef NAIVE_KV
#define NAIVE_KV 0
#endif
#ifndef NAIVE_INPROJ
#define NAIVE_INPROJ 0
#endif
#ifndef ONE_LAUNCH
#define ONE_LAUNCH 1
#endif

constexpr int D = 2048, BATCH = 2, SEQ = 8192, M = BATCH * SEQ, MEMLEN = 256;
constexpr int POOLW = 512, LRUW = 1024, MEMW = 512, MIXW = 2048, INW = 3072;
constexpr int NG = 4, EPG = 8, NE = 32, FF = 1024;
constexpr float ALPHA = 1.189207115002721f;
constexpr float EPS = 1e-5f;
constexpr int NT = 512;

constexpr size_t MiB = 1u << 20;
constexpr size_t WS_CTL = 0;
constexpr size_t WS_KB = 1 * MiB, WS_VT = 1 * MiB + 512 * 1024;
constexpr size_t WS_ASG_E = 2 * MiB, WS_ASG_S = WS_ASG_E + 128 * 1024, WS_ASG_W = WS_ASG_S + 128 * 1024, WS_ASG_R = WS_ASG_W + 128 * 1024;
constexpr size_t WS_TOKL = 6 * MiB;
constexpr size_t WS_AGG = 4 * MiB;
constexpr size_t WS_WPT = 8 * MiB, WS_WAT = WS_WPT + 128 * 1024, WS_WXT = WS_WAT + 256 * 1024;
constexpr size_t WS_WRH = 9 * MiB, WS_WRL = WS_WRH + 256 * 1024;
constexpr size_t WS_HC = 652 * MiB;
constexpr size_t WS_WGU = 16 * MiB;
constexpr size_t WS_WD = 272 * MiB;
constexpr size_t WS_WIN = 400 * MiB;
constexpr size_t WS_WOUT = 412 * MiB;
constexpr size_t WS_XB = 424 * MiB;
constexpr size_t WS_X1B = 424 * MiB;
constexpr size_t WS_HB = 488 * MiB;
constexpr size_t WS_MIX = 584 * MiB;
constexpr size_t WS_XG = 488 * MiB;
constexpr size_t WS_HD = 652 * MiB;
constexpr size_t WS_YB = 488 * MiB;
constexpr size_t WS_TMP = 652 * MiB;
constexpr size_t WS_YPOOL = WS_TMP, WS_AS = WS_TMP + 32 * MiB, WS_BS = WS_AS + 64 * MiB, WS_YLRU = WS_BS + 64 * MiB, WS_YMEM = WS_YLRU + 64 * MiB;
constexpr size_t WS_END = WS_YMEM + 32 * MiB;
constexpr int ROWS_MAX = 2 * M + NE * 256;
constexpr int CW_CNT = 64;

typedef unsigned short bf16_t;
DEVI float bf2f(bf16_t v) { return __uint_as_float(((unsigned)v) << 16); }
DEVI bf16_t f2bf(float f) { unsigned u = __float_as_uint(f); return (bf16_t)((u + 0x7fffu + ((u >> 16) & 1u)) >> 16); }

struct P { const float* in[26]; float* out; unsigned char* ws; };
enum { I_X = 0, I_MEM, I_WIN, I_WPOOL, I_PSCALE, I_CONVW, I_CONVB, I_WA, I_BA, I_WX, I_BX, I_LAM, I_WKV, I_MIXG, I_WOUT, I_LN1G, I_LN1B,
       I_WGROUP, I_BGROUP, I_WFINE, I_BFINE, I_WGATE, I_WUP, I_WDOWN, I_LN2G, I_LN2B };

DEVI float wave_sum(float v) {
#pragma unroll
    for (int o = 1; o < 64; o <<= 1) v += __shfl_xor(v, o);
    return v;
}
DEVI float wave_max(float v) {
#pragma unroll
    for (int o = 1; o < 64; o <<= 1) v = fmaxf(v, __shfl_xor(v, o));
    return v;
}
DEVI int permkey(int key) { const int k = key & 31; return (key & ~31) | (k & 16) | (((k >> 2) & 1) << 3) | (((k >> 3) & 1) << 2) | (k & 3); }

namespace pg8 {
#define PG8_LAS __attribute__((address_space(3)))
typedef unsigned short bf16_t;
typedef short bf16x8 __attribute__((ext_vector_type(8)));
typedef float f32x4 __attribute__((ext_vector_type(4)));
typedef unsigned u32x4 __attribute__((ext_vector_type(4)));
constexpr int BM = 256, BK = 64, HALF = 128, HTB = HALF * BK * 2  , STAGE_BYTES = 8 * HTB, NXCD = 8, WGM = 8;

__host__ __device__ __forceinline__ int lds_byte(int r, int c) { const int st = (r >> 4) * 2 + (c >> 5), rr = r & 15, cc = c & 31, ob = rr * 64 + cc * 2; return st * 1024 + (ob ^ (((ob >> 9) & 1) << 5)); }
__host__ __device__ __forceinline__ void stage_rc(int b, int& R, int& C) { const int st = b / 1024, sb = b % 1024, swz = sb ^ (((sb >> 9) & 1) << 5); R = (st >> 1) * 16 + swz / 64; C = (st & 1) * 32 + (swz % 64) / 2; }
__host__ __device__ __forceinline__ int perm32(int rho) { const int n = rho >> 4, i = rho & 15; return 8 * (i >> 2) + 4 * n + (i & 3); }

struct Unit { int pm, pn; };
struct Gemm { const bf16_t* A; const bf16_t* Bt; int M, N, K; const PG8_LAS int* rows = nullptr; };

struct StaticOrder {
    int nM, nN, nwg, G, c;
    __host__ __device__ void init(int M, int N, int G_, int c_) { nM = M / BM; nN = N / BM; nwg = nM * nN; G = G_; c = c_; }
    __host__ __device__ bool next(int i, Unit& u) const {
        const long L = (long)i * G + c; if (L >= nwg) return false;
        int wgid = (int)L; { const int q = nwg / NXCD, r = nwg % NXCD, xcd = wgid % NXCD, off = wgid / NXCD; wgid = (xcd < r ? xcd * (q + 1) : r * (q + 1) + (xcd - r) * q) + off; }
        const int nig = WGM * nN, gid = wgid / nig, fm = gid * WGM, gsz = (nM - fm) < WGM ? (nM - fm) : WGM;
        u.pm = fm + ((wgid % nig) % gsz); u.pn = (wgid % nig) / gsz; return true;
    }
    __device__ __forceinline__ void a_ready(const Unit&) const {}
    __device__ __forceinline__ void done(const Unit&) const {}
};

__device__ __forceinline__ unsigned cvt_pk_bf16(float lo, float hi) { unsigned r; asm volatile("v_cvt_pk_bf16_f32 %0, %1, %2" : "=v"(r) : "v"(lo), "v"(hi)); return r; }
typedef float f32x2 __attribute__((ext_vector_type(2)));
__device__ __forceinline__ f32x2 gelu_pk(f32x2 v) {
    const f32x2 av = __builtin_elementwise_abs(v), d = av * 0.2316418882f + 1.0f;
    f32x2 t; t.x = __builtin_amdgcn_rcpf(d.x); t.y = __builtin_amdgcn_rcpf(d.y);
    f32x2 q = t * 0.5307027145f + (-0.7265760135f); q = q * t + 0.7107068705f; q = q * t + (-0.142248368f); q = q * t + 0.127414796f; q = q * t;
    const f32x2 s = (v * v) * (-0.72134752044f);
    f32x2 e; e.x = __builtin_amdgcn_exp2f(s.x); e.y = __builtin_amdgcn_exp2f(s.y);
    const f32x2 m = v * (q * e), r = v - m;
    f32x2 o; o.x = v.x < 0.f ? m.x : r.x; o.y = v.y < 0.f ? m.y : r.y; return o;
}

template <int ACT  > struct EpiBf16 {
    static constexpr bool PERM = true, AFTER_DRAIN = false; static_assert(ACT == 0 || ACT == 1, "EpiBf16: ACT is 0 (none) or 1 (gelu_pk)");
    bf16_t* O; int ldc; const float* bias; int split_cols; size_t split_stride; float scale0;
    __device__ __forceinline__ void operator()(const f32x4 (&acc)[2][2][4][2], const Unit& u, int wr, int wc, int fr, int fq) const {
        const int row0 = u.pm * BM + wr * 64 + fr; int colt = u.pn * BM; bf16_t* base = O;
        float sc = 1.f; if (split_cols) { const int t = colt / split_cols; base += (size_t)t * split_stride; colt -= t * split_cols; if (t == 0) sc = scale0; }
        const int col0 = colt + wc * 32 + 8 * fq, bcol0 = u.pn * BM + wc * 32 + 8 * fq;
        f32x4 bv[2][2];
#pragma unroll
        for (int bj = 0; bj < 2; ++bj)
#pragma unroll
            for (int n = 0; n < 2; ++n) bv[bj][n] = bias ? *(const f32x4*)(bias + bcol0 + bj * HALF + 4 * n) : (f32x4){0.f, 0.f, 0.f, 0.f};
#pragma unroll
        for (int ai = 0; ai < 2; ++ai)
#pragma unroll
            for (int m = 0; m < 4; ++m) { bf16_t* rowp = base + (size_t)(row0 + ai * HALF + m * 16) * ldc + col0;
#pragma unroll
                for (int bj = 0; bj < 2; ++bj) { f32x4 v0 = acc[ai][bj][m][0] + bv[bj][0], v1 = acc[ai][bj][m][1] + bv[bj][1];
                    if (ACT == 1) { f32x2 a = gelu_pk((f32x2){v0[0], v0[1]}), b = gelu_pk((f32x2){v0[2], v0[3]}), c = gelu_pk((f32x2){v1[0], v1[1]}), d = gelu_pk((f32x2){v1[2], v1[3]});
                        v0 = (f32x4){a.x, a.y, b.x, b.y}; v1 = (f32x4){c.x, c.y, d.x, d.y}; }
                    v0 = v0 * sc; v1 = v1 * sc; u32x4 w; w.x = cvt_pk_bf16(v0[0], v0[1]); w.y = cvt_pk_bf16(v0[2], v0[3]); w.z = cvt_pk_bf16(v1[0], v1[1]); w.w = cvt_pk_bf16(v1[2], v1[3]);
                    *(u32x4*)(rowp + bj * HALF) = w; } }
    }
};

template <class Epi, class Sched, bool ALIGN_EPI = false, bool SP2 = false, bool GATHER = false>
__device__ __forceinline__ void gemm_phase(PG8_LAS unsigned char* lds, const Gemm g, const Sched& S, const Epi& E) {
    const int tid = opaque_tid(), wid = __builtin_amdgcn_readfirstlane(tid >> 6), lane = tid & 63, wr = wid >> 2, wc = wid & 3, fr = lane & 15, fq = lane >> 4;
    const int K = g.K, nt = K / BK;
    unsigned voffA[2], voffB[2];
#pragma unroll
    for (int i = 0; i < 2; ++i) { int R, C; stage_rc(tid * 16 + i * 8192, R, C); const int Rb = Epi::PERM ? ((R & ~31) + perm32(R & 31)) : R;
        voffA[i] = (unsigned)(R * K + C) * 2u; voffB[i] = (unsigned)(Rb * K + C) * 2u; }
    static_assert(!GATHER || SP2, "GATHER is wired into the SP2 loop only");
    unsigned vA0[2] = {0u, 0u}, vA1[2] = {0u, 0u}, nA0[2] = {0u, 0u}, nA1[2] = {0u, 0u};
    auto gather_offs = [&](int ui_, unsigned (&o0)[2], unsigned (&o1)[2]) {
#pragma unroll
        for (int i = 0; i < 2; ++i) { int R, C; stage_rc(tid * 16 + i * 8192, R, C);
            o0[i] = (unsigned)(g.rows[ui_ * 256 + R] * K + C) * 2u; o1[i] = (unsigned)(g.rows[ui_ * 256 + 128 + R] * K + C) * 2u; } };
#define PG8_STAGE_A(bufoff, gbase, HALFSEL, NEXTSEL) do { if constexpr (GATHER) { unsigned _v[2]; _Pragma("unroll") for (int _j = 0; _j < 2; ++_j) _v[_j] = (NEXTSEL) ? ((HALFSEL) ? nA1[_j] : nA0[_j]) : ((HALFSEL) ? vA1[_j] : vA0[_j]); \
        PG8_STAGE(bufoff, gbase, _v); } else { PG8_STAGE(bufoff, (gbase) + ((HALFSEL) ? hstep : 0), voffA); } } while (0)
    const size_t kstep = (size_t)(BK * 2);
    const size_t hstep = (size_t)HALF * K * 2;
    const size_t tstep = 2 * hstep;
    const unsigned ldsw = (unsigned)wid * 1024u;
    const int aoff = lds_byte(wr * 64 + fr, fq * 8), boff = lds_byte(wc * 32 + fr, fq * 8);
#define PG8_SA(b, h) (((b) * 2 + (h)) * HTB)
#define PG8_SB(b, h) ((4 + (b) * 2 + (h)) * HTB)
#define PG8_STAGE(bufoff, gbase, voff) do { _Pragma("unroll") for (int _i = 0; _i < 2; ++_i) \
        __builtin_amdgcn_global_load_lds((const unsigned*)((const char*)(gbase) + (voff)[_i]), (PG8_LAS unsigned*)(lds + (bufoff) + ldsw + _i * 8192), 16, 0, 0); } while (0)
#define PG8_LDA(dst, b, h) do { _Pragma("unroll") for (int m = 0; m < 4; ++m) _Pragma("unroll") for (int k = 0; k < 2; ++k) dst[m][k] = *(const PG8_LAS bf16x8*)(lds + PG8_SA(b, h) + aoff + m * 2048 + k * 1024); } while (0)
#define PG8_LDB(dst, b, h) do { _Pragma("unroll") for (int n = 0; n < 2; ++n) _Pragma("unroll") for (int k = 0; k < 2; ++k) dst[n][k] = *(const PG8_LAS bf16x8*)(lds + PG8_SB(b, h) + boff + n * 2048 + k * 1024); } while (0)
#define PG8_MMA(ai, bj, At, Bt) do { __builtin_amdgcn_s_setprio(1); _Pragma("unroll") for (int m = 0; m < 4; ++m) _Pragma("unroll") for (int n = 0; n < 2; ++n) _Pragma("unroll") for (int k = 0; k < 2; ++k) \
        acc[ai][bj][m][n] = __builtin_amdgcn_mfma_f32_16x16x32_bf16(Bt[n][k], At[m][k], acc[ai][bj][m][n], 0, 0, 0); __builtin_amdgcn_s_setprio(0); } while (0)
#define PG8_WAIT_V(n) asm volatile("s_waitcnt vmcnt(" #n ")" ::: "memory")
#define PG8_WAIT_L(n) asm volatile("s_waitcnt lgkmcnt(" #n ")" ::: "memory")
#define PG8_BAR __builtin_amdgcn_s_barrier()
#define PG8_SCHED __builtin_amdgcn_sched_barrier(0)
    Unit cur, nxt; int ui = 0;
    if (!S.next(0, cur)) return;
    f32x4 acc[2][2][4][2];
#pragma unroll
    for (int a = 0; a < 2; ++a)
#pragma unroll
        for (int b = 0; b < 2; ++b)
#pragma unroll
            for (int m = 0; m < 4; ++m)
#pragma unroll
                for (int n = 0; n < 2; ++n) acc[a][b][m][n] = (f32x4){0.f, 0.f, 0.f, 0.f};
    bf16x8 At[4][2], B0[2][2], B1[2][2];
    const char* cA = (const char*)g.A + (GATHER ? (size_t)0 : (size_t)cur.pm * tstep); const char* cB = (const char*)g.Bt + (size_t)cur.pn * tstep;
    if constexpr (GATHER) gather_offs(0, vA0, vA1);
    S.a_ready(cur);
    if constexpr (SP2) {
        PG8_STAGE(PG8_SB(0, 0), cB, voffB); PG8_STAGE(PG8_SB(0, 1), cB + hstep, voffB); PG8_STAGE_A(PG8_SA(0, 0), cA, 0, false); PG8_STAGE_A(PG8_SA(0, 1), cA, 1, false);
        if (wr == 1) PG8_BAR;
        PG8_WAIT_V(2); PG8_BAR;
        PG8_STAGE(PG8_SB(1, 0), cB + kstep, voffB); PG8_STAGE_A(PG8_SA(1, 0), cA + kstep, 0, false); PG8_STAGE(PG8_SB(1, 1), cB + hstep + kstep, voffB);
        PG8_WAIT_V(6); PG8_BAR;
    } else {
        PG8_STAGE(PG8_SB(0, 0), cB, voffB); PG8_STAGE(PG8_SA(0, 0), cA, voffA); PG8_STAGE(PG8_SB(0, 1), cB + hstep, voffB); PG8_STAGE(PG8_SA(0, 1), cA + hstep, voffA);
        if (wr == 1) PG8_BAR;
        PG8_WAIT_V(4); PG8_BAR;
        PG8_STAGE(PG8_SB(1, 0), cB + kstep, voffB); PG8_STAGE(PG8_SA(1, 0), cA + kstep, voffA); PG8_STAGE(PG8_SB(1, 1), cB + hstep + kstep, voffB);
        PG8_WAIT_V(6); PG8_BAR;
    }
    for (;;) {
        const bool has_next = S.next(ui + 1, nxt);
        const char* nA = (has_next && !GATHER) ? (const char*)g.A + (size_t)nxt.pm * tstep : cA; const char* nB = has_next ? (const char*)g.Bt + (size_t)nxt.pn * tstep : cB;
        if constexpr (GATHER) { if (has_next) gather_offs(ui + 1, nA0, nA1); else {
#pragma unroll
                for (int i = 0; i < 2; ++i) { nA0[i] = vA0[i]; nA1[i] = vA1[i]; } } }
        for (int t = 0; t < nt; t += 2) {
            const bool last = (t == nt - 2);
            const char* a1 = cA + (size_t)(t + 1) * kstep;
            const char* a2 = last ? nA : cA + (size_t)(t + 2) * kstep; const char* b2 = last ? nB : cB + (size_t)(t + 2) * kstep;
            const char* a3 = a2 + kstep; const char* b3 = b2 + kstep;
            if (last && has_next) S.a_ready(nxt);
            if constexpr (SP2) {
            PG8_LDB(B0, 0, 0); PG8_LDB(B1, 0, 1); PG8_SCHED; PG8_LDA(At, 0, 0); PG8_STAGE_A(PG8_SA(1, 1), a1, 1, false);
            PG8_WAIT_V(8); PG8_WAIT_L(0); PG8_BAR; PG8_MMA(0, 0, At, B0); PG8_MMA(0, 1, At, B1); PG8_BAR; PG8_SCHED;
            PG8_LDA(At, 0, 1); PG8_STAGE(PG8_SB(0, 0), b2, voffB); PG8_STAGE(PG8_SB(0, 1), b2 + hstep, voffB); PG8_STAGE_A(PG8_SA(0, 0), a2, 0, last);
            PG8_WAIT_V(8); PG8_WAIT_L(0); PG8_BAR; PG8_MMA(1, 0, At, B0); PG8_MMA(1, 1, At, B1); PG8_BAR; PG8_SCHED;
            PG8_LDB(B0, 1, 0); PG8_LDB(B1, 1, 1); PG8_SCHED; PG8_LDA(At, 1, 0); PG8_STAGE_A(PG8_SA(0, 1), a2, 1, last);
            PG8_WAIT_V(8); PG8_WAIT_L(0); PG8_BAR; PG8_MMA(0, 0, At, B0); PG8_MMA(0, 1, At, B1); PG8_BAR; PG8_SCHED;
            PG8_LDA(At, 1, 1); PG8_STAGE(PG8_SB(1, 0), b3, voffB); PG8_STAGE(PG8_SB(1, 1), b3 + hstep, voffB); PG8_STAGE_A(PG8_SA(1, 0), a3, 0, last);
            PG8_WAIT_V(8); PG8_WAIT_L(0); PG8_BAR; PG8_MMA(1, 0, At, B0); PG8_MMA(1, 1, At, B1); PG8_BAR; PG8_SCHED;
            } else {
            PG8_LDB(B0, 0, 0); PG8_SCHED; PG8_LDA(At, 0, 0); PG8_STAGE(PG8_SA(1, 1), a1 + hstep, voffA);
            PG8_WAIT_L(8); PG8_BAR; PG8_WAIT_L(0); PG8_MMA(0, 0, At, B0); PG8_BAR; PG8_SCHED;
            PG8_LDB(B1, 0, 1); PG8_STAGE(PG8_SB(0, 0), b2, voffB);
            PG8_BAR; PG8_WAIT_L(0); PG8_MMA(0, 1, At, B1); PG8_BAR;
            PG8_LDA(At, 0, 1); PG8_STAGE(PG8_SA(0, 0), a2, voffA);
            PG8_BAR; PG8_WAIT_L(0); PG8_MMA(1, 0, At, B0); PG8_BAR; PG8_SCHED;
            PG8_STAGE(PG8_SB(0, 1), b2 + hstep, voffB);
            PG8_WAIT_V(6); PG8_BAR; PG8_MMA(1, 1, At, B1); PG8_BAR;
            PG8_LDB(B0, 1, 0); PG8_SCHED; PG8_LDA(At, 1, 0); PG8_STAGE(PG8_SA(0, 1), a2 + hstep, voffA);
            PG8_WAIT_L(8); PG8_BAR; PG8_WAIT_L(0); PG8_MMA(0, 0, At, B0); PG8_BAR; PG8_SCHED;
            PG8_LDB(B1, 1, 1); PG8_STAGE(PG8_SB(1, 0), b3, voffB);
            PG8_BAR; PG8_WAIT_L(0); PG8_MMA(0, 1, At, B1); PG8_BAR;
            PG8_LDA(At, 1, 1); PG8_STAGE(PG8_SA(1, 0), a3, voffA);
            PG8_BAR; PG8_WAIT_L(0); PG8_MMA(1, 0, At, B0); PG8_BAR; PG8_SCHED;
            PG8_STAGE(PG8_SB(1, 1), b3 + hstep, voffB);
            PG8_WAIT_V(6); PG8_BAR; PG8_MMA(1, 1, At, B1); PG8_BAR;
            }
        }
        if constexpr (ALIGN_EPI) { if (wr == 0) PG8_BAR; }
        if constexpr (!Epi::AFTER_DRAIN) { E(acc, cur, wr, wc, fr, fq); S.done(cur); }
        if (!has_next) break;
#pragma unroll
        for (int a = 0; a < 2; ++a)
#pragma unroll
            for (int b = 0; b < 2; ++b)
#pragma unroll
                for (int m = 0; m < 4; ++m)
#pragma unroll
                    for (int n = 0; n < 2; ++n) acc[a][b][m][n] = (f32x4){0.f, 0.f, 0.f, 0.f};
        cur = nxt; cA = nA; cB = nB; ++ui;
        if constexpr (GATHER) {
#pragma unroll
            for (int i = 0; i < 2; ++i) { vA0[i] = nA0[i]; vA1[i] = nA1[i]; } }
        if constexpr (ALIGN_EPI) { if (wr == 1) PG8_BAR; }
    }
    PG8_WAIT_V(0);
    if constexpr (!ALIGN_EPI) { if (wr == 0) PG8_BAR; }
    PG8_BAR;
    if constexpr (Epi::AFTER_DRAIN) { E.fused(acc, cur, wr, wc, fr, fq, lds, wid, lane); S.done(cur); }
#undef PG8_SA
#undef PG8_SB
#undef PG8_STAGE
#undef PG8_STAGE_A
#undef PG8_LDA
#undef PG8_LDB
#undef PG8_MMA
#undef PG8_WAIT_V
#undef PG8_WAIT_L
#undef PG8_BAR
#undef PG8_SCHED
}
}


#define LAS __attribute__((address_space(3)))
typedef unsigned v4u __attribute__((ext_vector_type(4)));
typedef float f32x4 __attribute__((ext_vector_type(4)));
DEVI unsigned pk2(float lo, float hi) { return (unsigned)f2bf(lo) | ((unsigned)f2bf(hi) << 16); }
typedef float f32x2_t __attribute__((ext_vector_type(2))); typedef __bf16 bf16x2_t __attribute__((ext_vector_type(2)));
DEVI unsigned cvtpk(float lo, float hi) { f32x2_t v = {lo, hi}; bf16x2_t b = __builtin_convertvector(v, bf16x2_t); return __builtin_bit_cast(unsigned, b); }
constexpr int NWAVES = NT / 64;

struct EpiZ {
    static constexpr bool PERM = true, AFTER_DRAIN = false;
    const bf16_t* xb; bf16_t* zb; int ldc;
    __device__ __forceinline__ void operator()(const pg8::f32x4 (&acc)[2][2][4][2], const pg8::Unit& u, int wr, int wc, int fr, int fq) const {
        const int row0 = u.pm * pg8::BM + wr * 64 + fr, col0 = u.pn * pg8::BM + wc * 32 + 8 * fq;
#pragma unroll
        for (int ai = 0; ai < 2; ++ai)
#pragma unroll
            for (int m = 0; m < 4; ++m) { const size_t off = (size_t)(row0 + ai * pg8::HALF + m * 16) * ldc + col0;
#pragma unroll
                for (int bj = 0; bj < 2; ++bj) { const pg8::u32x4 xv = *(const pg8::u32x4*)(xb + off + bj * pg8::HALF);
                    const pg8::f32x4 a0 = acc[ai][bj][m][0], a1 = acc[ai][bj][m][1];
                    pg8::u32x4 w;
                    w.x = pg8::cvt_pk_bf16(fmaf(ALPHA, __uint_as_float(xv.x << 16), a0[0]), fmaf(ALPHA, __uint_as_float(xv.x & 0xffff0000u), a0[1]));
                    w.y = pg8::cvt_pk_bf16(fmaf(ALPHA, __uint_as_float(xv.y << 16), a0[2]), fmaf(ALPHA, __uint_as_float(xv.y & 0xffff0000u), a0[3]));
                    w.z = pg8::cvt_pk_bf16(fmaf(ALPHA, __uint_as_float(xv.z << 16), a1[0]), fmaf(ALPHA, __uint_as_float(xv.z & 0xffff0000u), a1[1]));
                    w.w = pg8::cvt_pk_bf16(fmaf(ALPHA, __uint_as_float(xv.w << 16), a1[2]), fmaf(ALPHA, __uint_as_float(xv.w & 0xffff0000u), a1[3]));
                    *(pg8::u32x4*)(zb + off + bj * pg8::HALF) = w; } }
    }
};

DEVI void transpose_item(const float* W, int ldn, int k0, int n0, bf16_t* dst, int K, LAS float* scr, int lane) {
    const int r = lane >> 3, q = lane & 7;
    f32x4 v[8];
#pragma unroll
    for (int i = 0; i < 8; ++i) v[i] = *(const f32x4*)(W + (size_t)(k0 + i * 8 + r) * ldn + n0 + 4 * q);
#pragma unroll
    for (int i = 0; i < 8; ++i) { LAS float* s = scr + (i * 8 + r) * 33 + 4 * q; s[0] = v[i][0]; s[1] = v[i][1]; s[2] = v[i][2]; s[3] = v[i][3]; }
    asm volatile("s_waitcnt lgkmcnt(0)" ::: "memory");
    const int c = lane & 7;
#pragma unroll
    for (int j = 0; j < 4; ++j) { const int n = (lane >> 3) + 8 * j; const LAS float* s = scr + (8 * c) * 33 + n;
        v4u o; o.x = pk2(s[0 * 33], s[1 * 33]); o.y = pk2(s[2 * 33], s[3 * 33]); o.z = pk2(s[4 * 33], s[5 * 33]); o.w = pk2(s[6 * 33], s[7 * 33]);
        *(v4u*)(dst + (size_t)n * K + 8 * c) = o; }
    asm volatile("s_waitcnt lgkmcnt(0)" ::: "memory");
}
struct TItem { const float* src; bf16_t* dst; int ldn, K; };
DEVI void ti_load(const TItem& t, int lane, f32x4 (&v)[8]) {
    const int r = lane >> 3, q = lane & 7;
#pragma unroll
    for (int i = 0; i < 8; ++i) v[i] = *(const f32x4*)(t.src + (size_t)(i * 8 + r) * t.ldn + 4 * q);
}
DEVI void ti_store(const TItem& t, int lane, const f32x4 (&v)[8], LAS float* scr) {
    const int r = lane >> 3, q = lane & 7;
#pragma unroll
    for (int i = 0; i < 8; ++i) { LAS float* s = scr + (i * 8 + r) * 33 + 4 * q; s[0] = v[i][0]; s[1] = v[i][1]; s[2] = v[i][2]; s[3] = v[i][3]; }
    asm volatile("s_waitcnt lgkmcnt(0)" ::: "memory");
    const int c = lane & 7;
#pragma unroll
    for (int j = 0; j < 4; ++j) { const int n = (lane >> 3) + 8 * j; const LAS float* s = scr + (8 * c) * 33 + n;
        v4u o; o.x = cvtpk(s[0 * 33], s[1 * 33]); o.y = cvtpk(s[2 * 33], s[3 * 33]); o.z = cvtpk(s[4 * 33], s[5 * 33]); o.w = cvtpk(s[6 * 33], s[7 * 33]);
        *(v4u*)(t.dst + (size_t)n * t.K + 8 * c) = o; }
    asm volatile("s_waitcnt lgkmcnt(0)" ::: "memory");
}
DEVI TItem expert_item(const P& p, int it) {
    constexpr int I_E = NE * (D / 64) * (FF / 32);
    const int fam = it / I_E, r = it % I_E, e = r >> 10, q = r & 1023;
    TItem t;
    if (fam < 2) { const int kb = q >> 5, nb = q & 31, n0 = nb * 32;
        t.src = p.in[fam == 0 ? I_WGATE : I_WUP] + (size_t)e * D * FF + (size_t)(kb * 64) * FF + n0; t.ldn = FF; t.K = D;
        t.dst = (bf16_t*)(p.ws + WS_WGU) + ((size_t)e * 2048 + (n0 >> 7) * 256 + fam * 128 + (n0 & 127)) * D + kb * 64; }
    else { const int kb = q >> 6, nb = q & 63, n0 = nb * 32;
        t.src = p.in[I_WDOWN] + (size_t)e * FF * D + (size_t)(kb * 64) * D + n0; t.ldn = D; t.K = FF;
        t.dst = (bf16_t*)(p.ws + WS_WD) + ((size_t)e * 2048 + n0) * FF + kb * 64; }
    return t;
}
DEVI void convert_experts(const P& p, unsigned char* lds, int vblk, int nblk) {
    const int tid = opaque_tid(), wave = __builtin_amdgcn_readfirstlane(tid >> 6), lane = tid & 63;
    LAS float* scr = (LAS float*)((LAS unsigned char*)lds + wave * 16384);
    const int gw = vblk * NWAVES + wave, NGW = nblk * NWAVES;
    constexpr int NIT = 3 * NE * (D / 64) * (FF / 32);
    TItem t0 = expert_item(p, gw < NIT ? gw : 0), t1 = expert_item(p, gw + NGW < NIT ? gw + NGW : 0), t2 = expert_item(p, gw + 2 * NGW < NIT ? gw + 2 * NGW : 0);
    f32x4 v0[8], v1[8], v2[8];
    ti_load(t0, lane, v0); ti_load(t1, lane, v1); ti_load(t2, lane, v2);
    for (int it = gw; it < NIT; it += NGW) {
        const int i3 = it + 3 * NGW;
        const TItem t3 = expert_item(p, i3 < NIT ? i3 : 0); f32x4 v3[8];
        ti_load(t3, lane, v3);
        ti_store(t0, lane, v0, scr);
        t0 = t1; t1 = t2; t2 = t3;
#pragma unroll
        for (int i = 0; i < 8; ++i) { v0[i] = v1[i]; v1[i] = v2[i]; v2[i] = v3[i]; }
    }
}
DEVI void p0_prologue(const P& p, unsigned char* lds) {
    const int tid = opaque_tid(), wave = tid >> 6, lane = tid & 63;
    LAS float* scr = (LAS float*)((LAS unsigned char*)lds + wave * 16384);
    const int gw = blockIdx.x * NWAVES + wave, NGW = gridDim.x * NWAVES;
    bf16_t* win_t = (bf16_t*)(p.ws + WS_WIN); bf16_t* wout_t = (bf16_t*)(p.ws + WS_WOUT);
    constexpr int I_IN = (D / 64) * (INW / 32), I_OUT = (MIXW / 64) * (D / 32);
    for (int it = gw; it < 160; it += NGW) {
        const int mat = it >> 3, q = it & 7, kb = q >> 2, nb = q & 3;
        const float* src = mat < 4 ? p.in[I_WPOOL] + (size_t)mat * 16384 : (mat < 12 ? p.in[I_WA] + (size_t)(mat - 4) * 16384 : p.in[I_WX] + (size_t)(mat - 12) * 16384);
        bf16_t* dstm = mat < 4 ? (bf16_t*)(p.ws + WS_WPT) + (size_t)mat * 16384 : (mat < 12 ? (bf16_t*)(p.ws + WS_WAT) + (size_t)(mat - 4) * 16384 : (bf16_t*)(p.ws + WS_WXT) + (size_t)(mat - 12) * 16384);
        transpose_item(src, 128, kb * 64, nb * 32, dstm + (size_t)(nb * 32) * 128 + kb * 64, 128, scr, lane);
    }
    for (int it = gw; it < I_IN + I_OUT; it += NGW) {
        if (it < I_IN) { const int kb = it / (INW / 32), nb = it % (INW / 32); transpose_item(p.in[I_WIN], INW, kb * 64, nb * 32, win_t + (size_t)(nb * 32) * D + kb * 64, D, scr, lane); }
        else { const int r = it - I_IN, kb = r / (D / 32), nb = r % (D / 32); transpose_item(p.in[I_WOUT], D, kb * 64, nb * 32, wout_t + (size_t)(nb * 32) * MIXW + kb * 64, MIXW, scr, lane); }
    }
    {
        bf16_t* wrh = (bf16_t*)(p.ws + WS_WRH); bf16_t* wrl = (bf16_t*)(p.ws + WS_WRL);
        for (int i = blockIdx.x * NT + tid; i < 64 * D; i += gridDim.x * NT) { const int n = i >> 11, kk = i & (D - 1);
            const float w = n < NE ? p.in[I_WFINE][(size_t)kk * NE + n] : (n < NE + NG ? p.in[I_WGROUP][(size_t)kk * NG + (n - NE)] : 0.f);
            const bf16_t hi = f2bf(w); wrh[i] = hi; wrl[i] = f2bf(w - bf2f(hi)); }
    }
    const float* x = p.in[I_X]; bf16_t* xb = (bf16_t*)(p.ws + WS_XB);
    const size_t n8 = (size_t)M * D / 8;
    for (size_t i = (size_t)blockIdx.x * NT + tid; i < n8; i += (size_t)gridDim.x * NT) {
        const f32x4 a = *(const f32x4*)(x + i * 8), b = *(const f32x4*)(x + i * 8 + 4);
        v4u o; o.x = pk2(a[0], a[1]); o.y = pk2(a[2], a[3]); o.z = pk2(b[0], b[1]); o.w = pk2(b[2], b[3]);
        *(v4u*)(xb + i * 8) = o;
    }
}
DEVI void p1_inproj(const P& p, unsigned char* lds) {
    pg8::Gemm g{(const bf16_t*)(p.ws + WS_XB), (const bf16_t*)(p.ws + WS_WIN), M, INW, D}; pg8::StaticOrder S; S.init(M, INW, (int)gridDim.x, (int)blockIdx.x);
    pg8::EpiBf16<0> E{(bf16_t*)(p.ws + WS_HB), INW, nullptr, 0, 0, 1.f};
    pg8::gemm_phase<pg8::EpiBf16<0>, pg8::StaticOrder, true, true>((PG8_LAS unsigned char*)lds, g, S, E);
}
DEVI void p3_outproj(const P& p, unsigned char* lds) {
    pg8::Gemm g{(const bf16_t*)(p.ws + WS_MIX), (const bf16_t*)(p.ws + WS_WOUT), M, D, MIXW}; pg8::StaticOrder S; S.init(M, D, (int)gridDim.x, (int)blockIdx.x);
    EpiZ E{(const bf16_t*)(p.ws + WS_XB), (bf16_t*)p.out, D};
    pg8::gemm_phase<EpiZ, pg8::StaticOrder, true, true>((PG8_LAS unsigned char*)lds, g, S, E);
}


constexpr int MOE_TAB_OFF = 131072;
struct MoeOrder {
    const LAS int* tab; int T, G, c;
    __device__ __forceinline__ bool next(int i, pg8::Unit& u) const {
        int mt, nt;
        if ((G & 63) == 0) { const int cpx = G >> 3, mpx = cpx >> 3, x = c & 7, j = c >> 3; mt = i * (G >> 3) + x * mpx + (j >> 3); nt = j & 7; }
        else { const int L = i * G + c; mt = L >> 3; nt = L & 7; }
        if (mt >= T) return false;
        u.pm = mt; u.pn = __builtin_amdgcn_readfirstlane(tab[64 + mt]) * 8 + nt; return true;
    }
    __device__ __forceinline__ void a_ready(const pg8::Unit&) const {}
    __device__ __forceinline__ void done(const pg8::Unit&) const {}
};
DEVI void moe_tables(const P& p, unsigned char* lds) {
    LAS int* tab = (LAS int*)((LAS unsigned char*)lds + MOE_TAB_OFF);
    const int* cnt = (const int*)(p.ws + WS_CTL) + CW_CNT;
    if (threadIdx.x == 0) { int o = 0, t = 0;
        for (int e = 0; e < NE; ++e) { tab[e] = o; const int nt = (cnt[e] + 255) >> 8; for (int q = 0; q < nt; ++q) tab[64 + t + q] = e; t += nt; o += nt * 256; }
        tab[NE] = o; tab[33] = t; }
    if (threadIdx.x < NE) tab[256 + threadIdx.x] = cnt[threadIdx.x];
    __syncthreads();
}
struct EpiGU {
    static constexpr bool PERM = true, AFTER_DRAIN = false;
    bf16_t* O;
    __device__ __forceinline__ void operator()(const pg8::f32x4 (&acc)[2][2][4][2], const pg8::Unit& u, int wr, int wc, int fr, int fq) const {
        const int row0 = u.pm * pg8::BM + wr * 64 + fr, col0 = (u.pn & 7) * 128 + wc * 32 + 8 * fq;
#pragma unroll
        for (int ai = 0; ai < 2; ++ai)
#pragma unroll
            for (int m = 0; m < 4; ++m) { bf16_t* rowp = O + (size_t)(row0 + ai * pg8::HALF + m * 16) * FF + col0;
                float h[8];
#pragma unroll
                for (int n = 0; n < 2; ++n)
#pragma unroll
                    for (int e = 0; e < 4; ++e) { const float g = acc[ai][0][m][n][e], up = acc[ai][1][m][n][e]; h[4 * n + e] = g * __builtin_amdgcn_rcpf(1.f + __expf(-g)) * up; }
                pg8::u32x4 w; w.x = pg8::cvt_pk_bf16(h[0], h[1]); w.y = pg8::cvt_pk_bf16(h[2], h[3]); w.z = pg8::cvt_pk_bf16(h[4], h[5]); w.w = pg8::cvt_pk_bf16(h[6], h[7]);
                *(pg8::u32x4*)rowp = w; }
    }
};
DEVI void p5_expert1(const P& p, unsigned char* lds) {
    moe_tables(p, lds);
    LAS int* tab = (LAS int*)((LAS unsigned char*)lds + MOE_TAB_OFF);
    MoeOrder S{tab, __builtin_amdgcn_readfirstlane(tab[33]), (int)gridDim.x, (int)blockIdx.x};
    LAS int* rows = tab + 512;
    { const int* tokl = (const int*)(p.ws + WS_TOKL); pg8::Unit u;
      for (int i = 0; i < 12 && S.next(i, u); ++i) { const int e = u.pn >> 3, first = tab[e] >> 8;
          if (threadIdx.x < 256) { const int lr = (u.pm - first) * 256 + (int)threadIdx.x; rows[i * 256 + threadIdx.x] = lr < tab[256 + e] ? tokl[e * M + lr] : 0; } } }
    __syncthreads();
    pg8::Gemm g{(const bf16_t*)(p.ws + WS_X1B), (const bf16_t*)(p.ws + WS_WGU), 0, 0, D, (const PG8_LAS int*)rows};
    EpiGU E{(bf16_t*)(p.ws + WS_HD)};
    pg8::gemm_phase<EpiGU, MoeOrder, true, true, true>((PG8_LAS unsigned char*)lds, g, S, E);
}
DEVI void p6_expert2(const P& p, unsigned char* lds) {
    moe_tables(p, lds);
    const LAS int* tab = (const LAS int*)((LAS unsigned char*)lds + MOE_TAB_OFF);
    MoeOrder S{tab, __builtin_amdgcn_readfirstlane(tab[33]), (int)gridDim.x, (int)blockIdx.x};
    pg8::Gemm g{(const bf16_t*)(p.ws + WS_HD), (const bf16_t*)(p.ws + WS_WD), 0, 0, FF};
    pg8::EpiBf16<0> E{(bf16_t*)(p.ws + WS_YB), D, nullptr, 2048, 0, 1.f};
    pg8::gemm_phase<pg8::EpiBf16<0>, MoeOrder, true, true>((PG8_LAS unsigned char*)lds, g, S, E);
}


constexpr int CW_BAR = 4096;
#define XB_TMO      128
#define XB_XCNT(j)  (256  + 64 * (j))
#define XB_XSUB(j)  (1280 + 64 * (j))
#define XB_XGEN(j)  (2304 + 64 * (j))
#define XB_TOP      3328
#define XB_TOPGEN   3392
#define XCD_BAR_WORDS 3456
#define XB_SPIN_CAP (1u << 18)

__device__ __forceinline__ unsigned xb_ld(unsigned* p)              { return __hip_atomic_load(p, __ATOMIC_RELAXED, __HIP_MEMORY_SCOPE_AGENT); }
__device__ __forceinline__ unsigned xb_add(unsigned* p, unsigned v) { return __hip_atomic_fetch_add(p, v, __ATOMIC_RELAXED, __HIP_MEMORY_SCOPE_AGENT); }
__device__ __forceinline__ unsigned xb_xcc_id() { return (unsigned)__builtin_amdgcn_s_getreg((3 << 11) | 20) & 0xFu; }
#define XB_SPIN(cond, bar) do { unsigned _sp = 0; while (cond) { __builtin_amdgcn_s_sleep(1); \
    if ((++_sp & 255u) == 0u) { if (xb_ld(&(bar)[XB_TMO])) break; if (_sp > XB_SPIN_CAP) { atomicAdd(&(bar)[XB_TMO], 1u); break; } } } } while (0)

struct XcdBarrier {
    unsigned* bar; unsigned x;
    volatile LAS unsigned* st;
};

__device__ __forceinline__ XcdBarrier xcd_barrier_post(unsigned* bar, volatile LAS unsigned* st) {
    XcdBarrier b; b.bar = bar; b.x = xb_xcc_id(); b.st = st;
    if (threadIdx.x == 0) (void)xb_add(&bar[XB_XCNT(b.x)], 1u);
    return b;
}
__device__ __forceinline__ void xcd_barrier_complete(unsigned* bar, unsigned x, unsigned& nloc, unsigned& nx) {
    const unsigned G = gridDim.x * gridDim.y * gridDim.z;
    unsigned sum, cnt, mine, sp = 0u;
    for (;;) {
        sum = 0u; cnt = 0u; mine = 0u;
#pragma unroll
        for (unsigned j = 0; j < 16; ++j) { const unsigned c = xb_ld(&bar[XB_XCNT(j)]); sum += c; cnt += (c > 0u) ? 1u : 0u; mine = (j == x) ? c : mine; }
        if (sum == G) break;
        __builtin_amdgcn_s_sleep(1);
        if ((++sp & 255u) == 0u) { if (xb_ld(&bar[XB_TMO])) break; if (sp > XB_SPIN_CAP) { atomicAdd(&bar[XB_TMO], 1u); break; } }
    }
    nloc = mine > 0u ? mine : 1u; nx = cnt > 0u ? cnt : 1u;
}

__device__ __forceinline__ void xcd_barrier(const XcdBarrier& b) {
    asm volatile("s_waitcnt vmcnt(0)" ::: "memory");
    __syncthreads();
    if (threadIdx.x == 0) {
        unsigned* bar = b.bar;
        __builtin_amdgcn_s_waitcnt(0);
        unsigned nloc = b.st[0], nx = b.st[1];
        if (nloc == 0u) { xcd_barrier_complete(bar, b.x, nloc, nx); b.st[0] = nloc; b.st[1] = nx; }
        const unsigned old = xb_add(&bar[XB_XSUB(b.x)], 1u);
        const unsigned gen = old / nloc;
        if (old + 1u == (gen + 1u) * nloc) {
            __builtin_amdgcn_fence(__ATOMIC_RELEASE, "agent");
            asm volatile("s_waitcnt vmcnt(0)" ::: "memory");
            const unsigned og = xb_add(&bar[XB_TOP], 1u);
            const unsigned tg = og / nx;
            if (og + 1u == (tg + 1u) * nx) xb_add(&bar[XB_TOPGEN], 1u);
            else XB_SPIN(xb_ld(&bar[XB_TOPGEN]) == tg, bar);
            __builtin_amdgcn_fence(__ATOMIC_ACQUIRE, "agent");
            xb_add(&bar[XB_XGEN(b.x)], 1u);
            asm volatile("s_waitcnt vmcnt(0)" ::: "memory");
        } else {
            XB_SPIN(xb_ld(&bar[XB_XGEN(b.x)]) == gen, bar);
            __builtin_amdgcn_fence(__ATOMIC_ACQUIRE, "agent");
            asm volatile("s_waitcnt vmcnt(0)" ::: "memory");
        }
    }
    __syncthreads();
}

typedef short bf16x8 __attribute__((ext_vector_type(8)));
typedef float f32x16 __attribute__((ext_vector_type(16)));
DEVI bf16x8 pack8(float a0, float a1, float a2, float a3, float a4, float a5, float a6, float a7) {
    v4u o; o.x = cvtpk(a0, a1); o.y = cvtpk(a2, a3); o.z = cvtpk(a4, a5); o.w = cvtpk(a6, a7); return __builtin_bit_cast(bf16x8, o); }
DEVI f32x16 zero16() { f32x16 z;
#pragma unroll
    for (int i = 0; i < 16; ++i) z[i] = 0.f; return z; }
#define MFMA32(a, b, c) __builtin_amdgcn_mfma_f32_32x32x16_bf16((a), (b), (c), 0, 0, 0)
DEVI float xhalf(float v) { return __shfl_xor(v, 32); }

DEVI void p0_kv(const P& p, unsigned char* lds) {
    const int tid = opaque_tid(), wave = tid >> 6, lane = tid & 63, r32 = lane & 31, hh = lane >> 5;
    const float* mem = p.in[I_MEM]; const float* wkv = p.in[I_WKV]; bf16_t* kb = (bf16_t*)(p.ws + WS_KB); bf16_t* vt = (bf16_t*)(p.ws + WS_VT);
    LAS float* red = (LAS float*)(LAS unsigned char*)lds;
    for (int blk = blockIdx.x; blk < 256; blk += gridDim.x) {
        const int rb = blk >> 4, cb = blk & 15, row0 = rb * 32, n0 = cb * 64;
        f32x16 acc0 = zero16(), acc1 = zero16();
        const float* arow = mem + (size_t)(row0 + r32) * D + wave * 256 + 8 * hh;
        const float* bcol = wkv + (size_t)(wave * 256 + 8 * hh) * (2 * MEMW) + n0 + r32;
#pragma unroll 2
        for (int ks = 0; ks < 16; ++ks) {
            const f32x4 a0 = *(const f32x4*)(arow + ks * 16), a1 = *(const f32x4*)(arow + ks * 16 + 4);
            float b0[8], b1[8];
#pragma unroll
            for (int j = 0; j < 8; ++j) { b0[j] = bcol[(size_t)(ks * 16 + j) * (2 * MEMW)]; b1[j] = bcol[(size_t)(ks * 16 + j) * (2 * MEMW) + 32]; }
            const bf16x8 af = pack8(a0[0], a0[1], a0[2], a0[3], a1[0], a1[1], a1[2], a1[3]);
            acc0 = MFMA32(af, pack8(b0[0], b0[1], b0[2], b0[3], b0[4], b0[5], b0[6], b0[7]), acc0);
            acc1 = MFMA32(af, pack8(b1[0], b1[1], b1[2], b1[3], b1[4], b1[5], b1[6], b1[7]), acc1);
        }
#pragma unroll
        for (int r = 0; r < 16; ++r) { red[(wave * 32 + r) * 64 + lane] = acc0[r]; red[(wave * 32 + 16 + r) * 64 + lane] = acc1[r]; }
        __syncthreads();
#pragma unroll
        for (int i = 0; i < 4; ++i) { const int e = tid + i * NT; float v = 0.f;
#pragma unroll
            for (int w = 0; w < 8; ++w) v += red[w * 2048 + e];
            const int tl = e >> 10, reg = (e >> 6) & 15, ln = e & 63;
            const int R = row0 + (reg & 3) + 8 * (reg >> 2) + 4 * (ln >> 5), n = n0 + 32 * tl + (ln & 31), b = R >> 8, key = R & 255;
            if (n < MEMW) { const int hd = n >> 7, d = n & 127; kb[((size_t)(b * 4 + hd) * MEMLEN + key) * 128 + d] = f2bf(v); }
            else { const int n2 = n - MEMW, hd = n2 >> 7, d = n2 & 127; vt[((size_t)(b * 4 + hd) * 128 + d) * MEMLEN + permkey(key)] = f2bf(v); } }
        __syncthreads();
    }
}

DEVI void p2_attn(const P& p, unsigned char* lds, int tile) {
    const int tid = opaque_tid(), wave = __builtin_amdgcn_readfirstlane(tid >> 6), lane = tid & 63, r32 = lane & 31, hh = lane >> 5;
    const int hd = wave >> 1, mt = wave & 1, t0 = tile * 64 + mt * 32, b = t0 / SEQ;
    const bf16_t* hb = (const bf16_t*)(p.ws + WS_HB); const bf16_t* kb = (const bf16_t*)(p.ws + WS_KB); const bf16_t* vt = (const bf16_t*)(p.ws + WS_VT); bf16_t* mix = (bf16_t*)(p.ws + WS_MIX);
    bf16x8 qf[8];
    const bf16_t* qrow = hb + (size_t)(t0 + r32) * INW + (POOLW + 2 * LRUW) + hd * 128 + hh * 8;
#pragma unroll
    for (int ks = 0; ks < 8; ++ks) qf[ks] = *(const bf16x8*)(qrow + ks * 16);
    f32x16 s[8];
    const bf16_t* kbase = kb + ((size_t)(b * 4 + hd) * MEMLEN + r32) * 128 + hh * 8;
    bf16x8 kf[2][8];
#pragma unroll
    for (int ks = 0; ks < 8; ++ks) kf[0][ks] = *(const bf16x8*)(kbase + ks * 16);
#pragma unroll
    for (int kt = 0; kt < 8; ++kt) { s[kt] = zero16();
        if (kt < 7) {
#pragma unroll
            for (int ks = 0; ks < 8; ++ks) kf[(kt + 1) & 1][ks] = *(const bf16x8*)(kbase + (size_t)(kt + 1) * 32 * 128 + ks * 16); }
#pragma unroll
        for (int ks = 0; ks < 8; ++ks) s[kt] = MFMA32(kf[kt & 1][ks], qf[ks], s[kt]);
        asm volatile("" ::: "memory"); }
    float mx = -3.0e38f;
#pragma unroll
    for (int kt = 0; kt < 8; ++kt)
#pragma unroll
        for (int r = 0; r < 16; ++r) mx = fmaxf(mx, s[kt][r]);
    mx = fmaxf(mx, xhalf(mx));
    const float sc = 0.08838834764831845f * 1.4426950408889634f; float sum = 0.f;
#pragma unroll
    for (int kt = 0; kt < 8; ++kt)
#pragma unroll
        for (int r = 0; r < 16; ++r) { const float pv = __builtin_amdgcn_exp2f((s[kt][r] - mx) * sc); s[kt][r] = pv; sum += pv; }
    sum += xhalf(sum);
    const float inv = 1.f / sum;
    f32x16 o[4];
#pragma unroll
    for (int dt = 0; dt < 4; ++dt) o[dt] = zero16();
    const bf16_t* vbase = vt + ((size_t)(b * 4 + hd) * 128 + r32) * MEMLEN + hh * 8;
#pragma unroll
    for (int kt = 0; kt < 8; ++kt) {
        bf16x8 vf[2][4];
#pragma unroll
        for (int si = 0; si < 2; ++si)
#pragma unroll
            for (int dt = 0; dt < 4; ++dt) vf[si][dt] = *(const bf16x8*)(vbase + (size_t)dt * 32 * MEMLEN + kt * 32 + si * 16);
#pragma unroll
        for (int si = 0; si < 2; ++si) {
            const bf16x8 pf = pack8(s[kt][8 * si], s[kt][8 * si + 1], s[kt][8 * si + 2], s[kt][8 * si + 3], s[kt][8 * si + 4], s[kt][8 * si + 5], s[kt][8 * si + 6], s[kt][8 * si + 7]);
#pragma unroll
            for (int dt = 0; dt < 4; ++dt) o[dt] = MFMA32(vf[si][dt], pf, o[dt]);
        }
        asm volatile("" ::: "memory");
    }
    float ss = 0.f;
#pragma unroll
    for (int dt = 0; dt < 4; ++dt)
#pragma unroll
        for (int r = 0; r < 16; ++r) { o[dt][r] *= inv; ss = fmaf(o[dt][r], o[dt][r], ss); }
    ss += xhalf(ss);
    LAS float* ssm = (LAS float*)(LAS unsigned char*)lds;
    if (hh == 0) ssm[wave * 32 + r32] = ss;
    __syncthreads();
    const float tot = (ssm[mt * 32 + r32] + ssm[(2 + mt) * 32 + r32]) + (ssm[(4 + mt) * 32 + r32] + ssm[(6 + mt) * 32 + r32]);
    const float rs = rsqrtf(tot * (1.f / MEMW) + EPS);
    const float* gain = p.in[I_MIXG] + POOLW + LRUW + hd * 128;
    bf16_t* mrow = mix + (size_t)(t0 + r32) * MIXW + POOLW + LRUW + hd * 128;
#pragma unroll
    for (int dt = 0; dt < 4; ++dt)
#pragma unroll
        for (int rg = 0; rg < 4; ++rg) { const int c = 32 * dt + 8 * rg + 4 * hh; const f32x4 g = *(const f32x4*)(gain + c);
            uint2 w; w.x = cvtpk(o[dt][4 * rg] * rs * g[0], o[dt][4 * rg + 1] * rs * g[1]); w.y = cvtpk(o[dt][4 * rg + 2] * rs * g[2], o[dt][4 * rg + 3] * rs * g[3]);
            *(uint2*)(mrow + c) = w; }
    __syncthreads();
}


typedef __amdgpu_buffer_rsrc_t rsrc_t;
typedef unsigned v2u __attribute__((ext_vector_type(2)));
DEVI rsrc_t mkrsrc(const void* ptr, unsigned bytes) { return __builtin_amdgcn_make_buffer_rsrc((void*)ptr, 0, (int)bytes, 0x00020000); }
DEVI v4u bl128(rsrc_t r, unsigned vo, unsigned so) { return __builtin_amdgcn_raw_buffer_load_b128(r, (int)vo, (int)so, 0); }
DEVI v2u bl64(rsrc_t r, unsigned vo, unsigned so) { return __builtin_amdgcn_raw_buffer_load_b64(r, (int)vo, (int)so, 0); }
DEVI unsigned bl32(rsrc_t r, unsigned vo, unsigned so) { return __builtin_amdgcn_raw_buffer_load_b32(r, (int)vo, (int)so, 0); }
DEVI f32x4 bl128f(rsrc_t r, unsigned vo, unsigned so) { return __builtin_bit_cast(f32x4, bl128(r, vo, so)); }
DEVI float bl32f(rsrc_t r, unsigned vo, unsigned so) { return __uint_as_float(bl32(r, vo, so)); }
DEVI void bs32(rsrc_t r, unsigned vo, unsigned so, unsigned v) { __builtin_amdgcn_raw_buffer_store_b32(v, r, (int)vo, (int)so, 0); }
DEVI void bs64(rsrc_t r, unsigned vo, unsigned so, v2u v) { __builtin_amdgcn_raw_buffer_store_b64(v, r, (int)vo, (int)so, 0); }

DEVI float bflo(unsigned w) { return __uint_as_float(w << 16); }
DEVI float bfhi(unsigned w) { return __uint_as_float(w & 0xffff0000u); }
DEVI void p2_pool(const P& p, unsigned char* lds, int tile) {
    const int tid = opaque_tid(), wave = __builtin_amdgcn_readfirstlane(tid >> 6), lane = tid & 63, r32 = lane & 31, hh = lane >> 5;
    const int g = wave >> 1, mt = wave & 1, W = 2 << g, t = tile * 64 + mt * 32 + r32, pos = t % SEQ;
    const bf16_t* hb = (const bf16_t*)(p.ws + WS_HB); const bf16_t* wpt = (const bf16_t*)(p.ws + WS_WPT) + (size_t)g * 16384; bf16_t* mix = (bf16_t*)(p.ws + WS_MIX);
    const float invc = 1.f / (float)((pos + 1 < W) ? pos + 1 : W);
    f32x16 acc[4];
#pragma unroll
    for (int nt = 0; nt < 4; ++nt) acc[nt] = zero16();
    const rsrc_t Rhb = mkrsrc(p.ws + WS_HB, (unsigned)((size_t)M * INW * 2));
    const unsigned vrow = (unsigned)(t * INW + hh * 8) * 2u, sg = (unsigned)(g * 128) * 2u;
    f32x4 sa[8], sb[8];
#pragma unroll
    for (int ks = 0; ks < 8; ++ks) { sa[ks] = (f32x4){0.f, 0.f, 0.f, 0.f}; sb[ks] = (f32x4){0.f, 0.f, 0.f, 0.f}; }
#pragma unroll 1
    for (int tau = 0; tau < W; tau += 2) {
        const bool ok0 = pos - tau >= 0, ok1 = pos - tau - 1 >= 0;
        const unsigned o0 = ok0 ? vrow - (unsigned)(tau * INW * 2) : vrow, o1 = ok1 ? vrow - (unsigned)((tau + 1) * INW * 2) : vrow;
        const float m0 = ok0 ? 1.f : 0.f, m1 = ok1 ? 1.f : 0.f;
        v4u r0[8], r1[8];
#pragma unroll
        for (int ks = 0; ks < 8; ++ks) { r0[ks] = bl128(Rhb, o0 + ks * 32, sg); r1[ks] = bl128(Rhb, o1 + ks * 32, sg); }
#pragma unroll
        for (int ks = 0; ks < 8; ++ks) {
            const f32x4 a0 = {bflo(r0[ks].x), bfhi(r0[ks].x), bflo(r0[ks].y), bfhi(r0[ks].y)}, b0 = {bflo(r0[ks].z), bfhi(r0[ks].z), bflo(r0[ks].w), bfhi(r0[ks].w)};
            const f32x4 a1 = {bflo(r1[ks].x), bfhi(r1[ks].x), bflo(r1[ks].y), bfhi(r1[ks].y)}, b1 = {bflo(r1[ks].z), bfhi(r1[ks].z), bflo(r1[ks].w), bfhi(r1[ks].w)};
            sa[ks] += a0 * m0 + a1 * m1; sb[ks] += b0 * m0 + b1 * m1;
        }
    }
    {
        v4u rc[8];
#pragma unroll
        for (int ks = 0; ks < 8; ++ks) rc[ks] = bl128(Rhb, vrow + ks * 32, sg);
#pragma unroll
        for (int ks = 0; ks < 8; ++ks) {
            const f32x4 ca = {bflo(rc[ks].x), bfhi(rc[ks].x), bflo(rc[ks].y), bfhi(rc[ks].y)}, cb = {bflo(rc[ks].z), bfhi(rc[ks].z), bflo(rc[ks].w), bfhi(rc[ks].w)};
            const f32x4 da = sa[ks] * invc - ca, db = sb[ks] * invc - cb;
            const bf16x8 df = pack8(da[0], da[1], da[2], da[3], db[0], db[1], db[2], db[3]);
#pragma unroll
            for (int nt = 0; nt < 4; ++nt) { const bf16x8 wf = *(const bf16x8*)(wpt + (size_t)(nt * 32 + r32) * 128 + ks * 16 + hh * 8); acc[nt] = MFMA32(wf, df, acc[nt]); }
        }
    }
    const float* psc = p.in[I_PSCALE] + g * 128; float ss = 0.f;
#pragma unroll
    for (int nt = 0; nt < 4; ++nt)
#pragma unroll
        for (int rg = 0; rg < 4; ++rg) { const f32x4 s4 = *(const f32x4*)(psc + nt * 32 + 8 * rg + 4 * hh);
#pragma unroll
            for (int e = 0; e < 4; ++e) { const float y = acc[nt][4 * rg + e] * s4[e]; acc[nt][4 * rg + e] = y; ss = fmaf(y, y, ss); } }
    ss += xhalf(ss);
    LAS float* ssm = (LAS float*)(LAS unsigned char*)lds;
    if (hh == 0) ssm[wave * 32 + r32] = ss;
    __syncthreads();
    const float tot = (ssm[mt * 32 + r32] + ssm[(2 + mt) * 32 + r32]) + (ssm[(4 + mt) * 32 + r32] + ssm[(6 + mt) * 32 + r32]);
    const float rs = rsqrtf(tot * (1.f / POOLW) + EPS);
    const float* gain = p.in[I_MIXG] + g * 128;
    bf16_t* mrow = mix + (size_t)t * MIXW + g * 128;
#pragma unroll
    for (int nt = 0; nt < 4; ++nt)
#pragma unroll
        for (int rg = 0; rg < 4; ++rg) { const int c = 32 * nt + 8 * rg + 4 * hh; const f32x4 gv = *(const f32x4*)(gain + c);
            uint2 w; w.x = cvtpk(acc[nt][4 * rg] * rs * gv[0], acc[nt][4 * rg + 1] * rs * gv[1]); w.y = cvtpk(acc[nt][4 * rg + 2] * rs * gv[2], acc[nt][4 * rg + 3] * rs * gv[3]);
            *(uint2*)(mrow + c) = w; }
    __syncthreads();
}

DEVI float fast_sigmoid(float v) { return __builtin_amdgcn_rcpf(1.f + __expf(-v)); }
DEVI float one_minus_exp(float x) {
    const float ser = -x * (1.f + x * (0.5f + x * (0.16666667f + x * (0.041666668f + x * 0.0083333338f))));
    const float dir = 1.f - __expf(x);
    return (x > -0.125f) ? ser : dir;
}
DEVI void p2_lru_local(const P& p, int tile) {
    const int tid = opaque_tid(), h = __builtin_amdgcn_readfirstlane(tid >> 6), lane = tid & 63, r32 = lane & 31, hh = lane >> 5;
    const int t0 = tile * 64, pos0 = t0 % SEQ;
    const rsrc_t Rhb = mkrsrc(p.ws + WS_HB, (unsigned)((size_t)M * INW * 2)), Rwa = mkrsrc(p.ws + WS_WAT, 8 * 16384 * 2), Rwx = mkrsrc(p.ws + WS_WXT, 8 * 16384 * 2);
    const rsrc_t Rhc = mkrsrc(p.ws + WS_HC, (unsigned)((size_t)M * LRUW * 4)), Ragg = mkrsrc(p.ws + WS_AGG, 256 * LRUW * 8);
    const rsrc_t Rcw = mkrsrc(p.in[I_CONVW], 4 * LRUW * 4), Rcb = mkrsrc(p.in[I_CONVB], LRUW * 4), Rba = mkrsrc(p.in[I_BA], LRUW * 4), Rbx = mkrsrc(p.in[I_BX], LRUW * 4), Rlam = mkrsrc(p.in[I_LAM], LRUW * 4);
    const unsigned vo8 = (unsigned)hh * 32u;
    const unsigned voB = (unsigned)(r32 * 128 + hh * 8) * 2u;
    const unsigned sch = (unsigned)h * 128u;
    float hcar[4], Acar[4];
#pragma unroll
    for (int nt = 0; nt < 4; ++nt) { hcar[nt] = 0.f; Acar[nt] = 1.f; }
#pragma unroll 1
    for (int mt = 0; mt < 2; ++mt) {
        const int t = t0 + mt * 32 + r32, pos = pos0 + mt * 32 + r32;
        unsigned rofs[4]; float rm[4];
#pragma unroll
        for (int tau = 0; tau < 4; ++tau) { const bool ok = (pos - 3 + tau) >= 0;
            rofs[tau] = (unsigned)((ok ? t - 3 + tau : t) * INW + hh * 8) * 2u; rm[tau] = ok ? 1.f : 0.f; }
        bf16x8 af[8];
        {
            v4u raw[8][4];
#pragma unroll
            for (int ks = 0; ks < 8; ++ks)
#pragma unroll
                for (int tau = 0; tau < 4; ++tau) raw[ks][tau] = bl128(Rhb, rofs[tau] + ks * 32, (POOLW + sch) * 2u);
#pragma unroll
            for (int ks = 0; ks < 8; ++ks) {
                f32x4 ua = bl128f(Rcb, vo8 + ks * 64, sch * 4u), ub = bl128f(Rcb, vo8 + ks * 64 + 16, sch * 4u);
#pragma unroll
                for (int tau = 0; tau < 4; ++tau) {
                    const f32x4 w0 = bl128f(Rcw, vo8 + ks * 64, (tau * LRUW + sch) * 4u), w1 = bl128f(Rcw, vo8 + ks * 64 + 16, (tau * LRUW + sch) * 4u);
                    const v4u rw = raw[ks][tau];
                    f32x4 xa = {bflo(rw.x), bfhi(rw.x), bflo(rw.y), bfhi(rw.y)}, xb = {bflo(rw.z), bfhi(rw.z), bflo(rw.w), bfhi(rw.w)};
                    ua += (w0 * rm[tau]) * xa; ub += (w1 * rm[tau]) * xb;
                }
                af[ks] = pack8(ua[0], ua[1], ua[2], ua[3], ub[0], ub[1], ub[2], ub[3]);
            }
        }
#pragma unroll
        for (int nt = 0; nt < 4; ++nt) {
            asm volatile("" ::: "memory"); __builtin_amdgcn_sched_barrier(0);
            f32x16 ra = zero16(), rx = zero16(), uc = zero16();
            const unsigned sw = (unsigned)(h * 16384 + nt * 4096) * 2u;
#pragma unroll
            for (int ks = 0; ks < 8; ++ks) {
                const bf16x8 wa = __builtin_bit_cast(bf16x8, bl128(Rwa, voB + ks * 32, sw)), wx = __builtin_bit_cast(bf16x8, bl128(Rwx, voB + ks * 32, sw));
                ra = MFMA32(af[ks], wa, ra); rx = MFMA32(af[ks], wx, rx);
            }
#pragma unroll
            for (int q = 0; q < 2; ++q) {
                const int jj = r32 - 16 * q - 8 * hh;
                v4u idw;
                idw.x = (jj == 0) ? 0x00003F80u : ((jj == 1) ? 0x3F800000u : 0u); idw.y = (jj == 2) ? 0x00003F80u : ((jj == 3) ? 0x3F800000u : 0u);
                idw.z = (jj == 4) ? 0x00003F80u : ((jj == 5) ? 0x3F800000u : 0u); idw.w = (jj == 6) ? 0x00003F80u : ((jj == 7) ? 0x3F800000u : 0u);
                uc = MFMA32(af[2 * nt + q], __builtin_bit_cast(bf16x8, idw), uc);
            }
            const unsigned vc = (unsigned)r32 * 4u, sc4 = (sch + nt * 32) * 4u;
            const float bac = bl32f(Rba, vc, sc4), bxc = bl32f(Rbx, vc, sc4), sp8 = -8.f * log1pf(__expf(-bl32f(Rlam, vc, sc4)));
#pragma unroll
            for (int r = 0; r < 16; ++r) {
                const float rr = fast_sigmoid(ra[r] + bac), ii = fast_sigmoid(rx[r] + bxc);
                const float la = rr * sp8, a = __expf(la), mult = __builtin_amdgcn_sqrtf(fmaxf(one_minus_exp(2.f * la), 0.f));
                ra[r] = a; rx[r] = mult * ii * uc[r];
            }
            float hc = hcar[nt], Ac = Acar[nt];
#pragma unroll
            for (int g4 = 0; g4 < 4; ++g4) {
                const int rb = g4 * 4;
                const float a0 = ra[rb], a1 = ra[rb + 1], a2 = ra[rb + 2], a3 = ra[rb + 3];
                const float b0 = rx[rb], b1 = rx[rb + 1], b2 = rx[rb + 2], b3 = rx[rb + 3];
                const float P0 = a0, l0 = b0, P1 = a1 * P0, l1 = fmaf(a1, l0, b1), P2 = a2 * P1, l2 = fmaf(a2, l1, b2), P3 = a3 * P2, l3 = fmaf(a3, l2, b3);
                const float he = fmaf(P3, hc, l3), Ae = P3 * Ac;
                float th = xhalf(he), tA = xhalf(Ae);
                if (hh) { hc = th; Ac = tA; }
                const float h0 = fmaf(P0, hc, l0), h1 = fmaf(P1, hc, l1), h2 = fmaf(P2, hc, l2), h3 = fmaf(P3, hc, l3);
                const float c0 = P0 * Ac, c1 = P1 * Ac, c2 = P2 * Ac, c3 = P3 * Ac;
                rx[rb] = h0; rx[rb + 1] = h1; rx[rb + 2] = h2; rx[rb + 3] = h3;
                ra[rb] = c0; ra[rb + 1] = c1; ra[rb + 2] = c2; ra[rb + 3] = c3;
                th = xhalf(h3); tA = xhalf(c3);
                if (!hh) { hc = th; Ac = tA; }
            }
            hcar[nt] = hc; Acar[nt] = Ac;
            const unsigned vhc = (unsigned)(4 * hh * LRUW + r32) * 4u;
#pragma unroll
            for (int r = 0; r < 16; ++r) bs32(Rhc, vhc, (unsigned)((t0 + mt * 32 + (r & 3) + 8 * (r >> 2)) * LRUW + sch + nt * 32) * 4u, cvtpk(rx[r], ra[r]));
            if (mt == 1 && !hh) { v2u ag = {__float_as_uint(Ac), __float_as_uint(hc)}; bs64(Ragg, (unsigned)r32 * 8u, (unsigned)(tile * LRUW + sch + nt * 32) * 8u, ag); }
        }
    }
}
DEVI void p2_lru_final(const P& p, unsigned char* lds, int tile) {
    const int tid = opaque_tid(), h = __builtin_amdgcn_readfirstlane(tid >> 6), lane = tid & 63;
    const int t0 = tile * 64, j0 = (tile / (SEQ / 64)) * (SEQ / 64);
    const rsrc_t Rhb = mkrsrc(p.ws + WS_HB, (unsigned)((size_t)M * INW * 2)), Rhc = mkrsrc(p.ws + WS_HC, (unsigned)((size_t)M * LRUW * 4)), Ragg = mkrsrc(p.ws + WS_AGG, 256 * LRUW * 8);
    const rsrc_t Rmix = mkrsrc(p.ws + WS_MIX, (unsigned)((size_t)M * MIXW * 2));
    const unsigned vl = (unsigned)lane;
    float h0 = 0.f, h1 = 0.f;
    for (int j = j0; j < tile; j += 32) {
        f32x4 ag[32];
#pragma unroll
        for (int q = 0; q < 32; ++q) { const int jq = (j + q < tile) ? j + q : j; ag[q] = bl128f(Ragg, vl * 16u, (unsigned)(jq * LRUW + h * 128) * 8u); }
#pragma unroll
        for (int q = 0; q < 32; ++q) { const bool ok = j + q < tile; h0 = ok ? fmaf(ag[q][0], h0, ag[q][1]) : h0; h1 = ok ? fmaf(ag[q][2], h1, ag[q][3]) : h1; }
    }
    unsigned yp[64]; float sq[64];
#pragma unroll
    for (int tb = 0; tb < 64; tb += 32) {
        v2u hc2[32]; unsigned gt[32];
#pragma unroll
        for (int q = 0; q < 32; ++q) { hc2[q] = bl64(Rhc, vl * 8u, (unsigned)((t0 + tb + q) * LRUW + h * 128) * 4u); gt[q] = bl32(Rhb, vl * 4u, (unsigned)((t0 + tb + q) * INW + POOLW + LRUW + h * 128) * 2u); }
#pragma unroll
        for (int q = 0; q < 32; ++q) {
            const float g0 = bflo(gt[q]), g1 = bfhi(gt[q]);
            const float u0 = 0.7978845608028654f * (g0 + 0.044715f * g0 * g0 * g0), u1 = 0.7978845608028654f * (g1 + 0.044715f * g1 * g1 * g1);
            const float y0 = g0 * __builtin_amdgcn_rcpf(1.f + __expf(-2.f * u0)) * fmaf(bfhi(hc2[q].x), h0, bflo(hc2[q].x));
            const float y1 = g1 * __builtin_amdgcn_rcpf(1.f + __expf(-2.f * u1)) * fmaf(bfhi(hc2[q].y), h1, bflo(hc2[q].y));
            yp[tb + q] = cvtpk(y0, y1); sq[tb + q] = fmaf(y0, y0, y1 * y1);
        }
        asm volatile("" ::: "memory");
    }
#pragma unroll
    for (int o = 32; o >= 1; o >>= 1) {
        const bool up = (lane & o) != 0;
#pragma unroll
        for (int i = 0; i < o; ++i) { const float send = up ? sq[i] : sq[i + o], keep = up ? sq[i + o] : sq[i]; sq[i] = keep + __shfl_xor(send, o); }
    }
    LAS float* ssm = (LAS float*)(LAS unsigned char*)lds;
    ssm[h * 64 + lane] = sq[0];
    __syncthreads();
    float tot = 0.f;
#pragma unroll
    for (int w = 0; w < 8; ++w) tot += ssm[w * 64 + lane];
    ssm[512 + h * 64 + lane] = rsqrtf(tot * (1.f / LRUW) + EPS);
    __syncthreads();
    const float gn0 = p.in[I_MIXG][POOLW + h * 128 + 2 * lane], gn1 = p.in[I_MIXG][POOLW + h * 128 + 2 * lane + 1];
#pragma unroll
    for (int tt = 0; tt < 64; ++tt) { const float rs = ssm[512 + h * 64 + tt];
        bs32(Rmix, vl * 4u, (unsigned)((t0 + tt) * MIXW + POOLW + h * 128) * 2u, cvtpk(bflo(yp[tt]) * rs * gn0, bfhi(yp[tt]) * rs * gn1)); }
    __syncthreads();
}

DEVI void p4_route(const P& p, unsigned char* lds, int tile) {
    const int tid = opaque_tid(), wave = __builtin_amdgcn_readfirstlane(tid >> 6), lane = tid & 63, r32 = lane & 31, hh = lane >> 5;
    const int t0 = tile * 64;
    const bf16_t* z = (const bf16_t*)p.out; bf16_t* x1b = (bf16_t*)(p.ws + WS_X1B);
    const float* g1 = p.in[I_LN1G]; const float* b1 = p.in[I_LN1B];
    LAS float* st = (LAS float*)(LAS unsigned char*)lds;
    LAS float* red = (LAS float*)((LAS unsigned char*)lds + 1024);
    LAS float* lgs = (LAS float*)((LAS unsigned char*)lds + 1024 + 73728);
    LAS int* hist = (LAS int*)((LAS unsigned char*)lds + 1024 + 73728 + 9728);
    if (tid < 64) hist[tid] = 0;
    {
        uint2 zq[8][8];
#pragma unroll
        for (int rr = 0; rr < 8; ++rr)
#pragma unroll
            for (int j = 0; j < 8; ++j) zq[rr][j] = *(const uint2*)(z + (size_t)(t0 + wave * 8 + rr) * D + j * 256 + lane * 4);
        f32x4 g[8], bb[8];
#pragma unroll
        for (int j = 0; j < 8; ++j) { g[j] = *(const f32x4*)(g1 + j * 256 + lane * 4); bb[j] = *(const f32x4*)(b1 + j * 256 + lane * 4); }
#pragma unroll
        for (int rr = 0; rr < 8; ++rr) {
            const int t = t0 + wave * 8 + rr;
            f32x4 v[8]; float s = 0.f;
#pragma unroll
            for (int j = 0; j < 8; ++j) { v[j] = (f32x4){bflo(zq[rr][j].x), bfhi(zq[rr][j].x), bflo(zq[rr][j].y), bfhi(zq[rr][j].y)}; s += (v[j][0] + v[j][1]) + (v[j][2] + v[j][3]); }
            const float mean = wave_sum(s) * (1.f / D); float s2 = 0.f;
#pragma unroll
            for (int j = 0; j < 8; ++j) { v[j] = v[j] - mean; s2 += (v[j][0] * v[j][0] + v[j][1] * v[j][1]) + (v[j][2] * v[j][2] + v[j][3] * v[j][3]); }
            const float rstd = rsqrtf(wave_sum(s2) * (1.f / D) + EPS);
            if (lane == 0) { st[(wave * 8 + rr) * 2] = mean; st[(wave * 8 + rr) * 2 + 1] = rstd; }
#pragma unroll
            for (int j = 0; j < 8; ++j) { const f32x4 o = v[j] * rstd * g[j] + bb[j]; uint2 w; w.x = cvtpk(o[0], o[1]); w.y = cvtpk(o[2], o[3]);
                *(uint2*)(x1b + (size_t)t * D + j * 256 + lane * 4) = w; }
        }
    }
    __syncthreads();
    const bf16_t* wrh = (const bf16_t*)(p.ws + WS_WRH); const bf16_t* wrl = (const bf16_t*)(p.ws + WS_WRL);
    f32x16 acc[2][2];
#pragma unroll
    for (int a = 0; a < 2; ++a)
#pragma unroll
        for (int b = 0; b < 2; ++b) acc[a][b] = zero16();
    float mu[2], rs[2];
#pragma unroll
    for (int tt = 0; tt < 2; ++tt) { mu[tt] = st[(tt * 32 + r32) * 2]; rs[tt] = st[(tt * 32 + r32) * 2 + 1]; }
#pragma unroll 4
    for (int ks = 0; ks < 16; ++ks) {
        const int k0 = wave * 256 + ks * 16 + hh * 8;
        const f32x4 ga = *(const f32x4*)(g1 + k0), gb = *(const f32x4*)(g1 + k0 + 4), ba = *(const f32x4*)(b1 + k0), bb = *(const f32x4*)(b1 + k0 + 4);
        bf16x8 xh[2], xl[2];
#pragma unroll
        for (int tt = 0; tt < 2; ++tt) {
            const v4u zq = *(const v4u*)(z + (size_t)(t0 + tt * 32 + r32) * D + k0);
            const f32x4 za = {bflo(zq.x), bfhi(zq.x), bflo(zq.y), bfhi(zq.y)}, zb = {bflo(zq.z), bfhi(zq.z), bflo(zq.w), bfhi(zq.w)};
            const f32x4 xa = (za - mu[tt]) * rs[tt] * ga + ba, xb = (zb - mu[tt]) * rs[tt] * gb + bb;
            v4u hw; hw.x = cvtpk(xa[0], xa[1]); hw.y = cvtpk(xa[2], xa[3]); hw.z = cvtpk(xb[0], xb[1]); hw.w = cvtpk(xb[2], xb[3]);
            v4u lw; lw.x = cvtpk(xa[0] - bflo(hw.x), xa[1] - bfhi(hw.x)); lw.y = cvtpk(xa[2] - bflo(hw.y), xa[3] - bfhi(hw.y));
            lw.z = cvtpk(xb[0] - bflo(hw.z), xb[1] - bfhi(hw.z)); lw.w = cvtpk(xb[2] - bflo(hw.w), xb[3] - bfhi(hw.w));
            xh[tt] = __builtin_bit_cast(bf16x8, hw); xl[tt] = __builtin_bit_cast(bf16x8, lw);
        }
#pragma unroll
        for (int nt = 0; nt < 2; ++nt) {
            const bf16x8 wh = *(const bf16x8*)(wrh + (size_t)(nt * 32 + r32) * D + k0), wl = *(const bf16x8*)(wrl + (size_t)(nt * 32 + r32) * D + k0);
#pragma unroll
            for (int tt = 0; tt < 2; ++tt) { acc[nt][tt] = MFMA32(wh, xh[tt], acc[nt][tt]); acc[nt][tt] = MFMA32(wh, xl[tt], acc[nt][tt]); acc[nt][tt] = MFMA32(wl, xh[tt], acc[nt][tt]); }
        }
    }
#pragma unroll
    for (int tt = 0; tt < 2; ++tt) {
#pragma unroll
        for (int r = 0; r < 16; ++r) { const int n = (r & 3) + 8 * (r >> 2) + 4 * hh; red[(wave * 36 + n) * 64 + tt * 32 + r32] = acc[0][tt][r]; }
        if (hh == 0) {
#pragma unroll
            for (int r = 0; r < 4; ++r) red[(wave * 36 + 32 + r) * 64 + tt * 32 + r32] = acc[1][tt][r]; }
    }
    __syncthreads();
    {
        const int tok = tid & 63, part = tid >> 6;
#pragma unroll
        for (int q = 0; q < 5; ++q) { const int n = part * 5 + q; if (n < 36) { float sacc = 0.f;
#pragma unroll
                for (int w = 0; w < 8; ++w) sacc += red[(w * 36 + n) * 64 + tok];
                lgs[tok * 37 + n] = sacc; } }
    }
    __syncthreads();
    int ea = 0, eb = 0, ra_ = 0, rb_ = 0; float w0 = 0.f, w1 = 0.f;
    if (tid < 64) {
        const float* bg = p.in[I_BGROUP]; const float* bfine = p.in[I_BFINE];
        float lg[4];
#pragma unroll
        for (int o = 0; o < 4; ++o) lg[o] = lgs[tid * 37 + 32 + o] + bg[o];
        int gi = 0; float gm = lg[0];
#pragma unroll
        for (int o = 1; o < 4; ++o) if (lg[o] > gm) { gm = lg[o]; gi = o; }
        float ge = 0.f;
#pragma unroll
        for (int o = 0; o < 4; ++o) ge += __expf(lg[o] - gm);
        const float gp = 1.f / ge;
        float fs[8];
#pragma unroll
        for (int j = 0; j < 8; ++j) fs[j] = lgs[tid * 37 + gi * 8 + j] + bfine[gi * 8 + j];
        int i0 = 0; float l0 = fs[0];
#pragma unroll
        for (int j = 1; j < 8; ++j) if (fs[j] > l0) { l0 = fs[j]; i0 = j; }
        int i1 = -1; float l1 = -3.0e38f;
#pragma unroll
        for (int j = 0; j < 8; ++j) if (j != i0 && fs[j] > l1) { l1 = fs[j]; i1 = j; }
        const float e1 = __expf(l1 - l0); w0 = gp / (1.f + e1); w1 = gp * e1 / (1.f + e1);
        ea = gi * 8 + i0; eb = gi * 8 + i1;
        ra_ = atomicAdd((int*)&hist[ea], 1); rb_ = atomicAdd((int*)&hist[eb], 1);
    }
    __syncthreads();
    if (tid < 32) { int* cnt = (int*)(p.ws + WS_CTL) + CW_CNT; const int c = hist[tid]; hist[32 + tid] = c ? atomicAdd(&cnt[tid], c) : 0; }
    __syncthreads();
    if (tid < 64) {
        int* asg_e = (int*)(p.ws + WS_ASG_E); int* asg_s = (int*)(p.ws + WS_ASG_S); float* asg_w = (float*)(p.ws + WS_ASG_W);
        const int t = t0 + tid;
        const int sa = hist[32 + ea] + ra_, sb = hist[32 + eb] + rb_; int* tokl = (int*)(p.ws + WS_TOKL);
        asg_e[2 * t] = ea; asg_e[2 * t + 1] = eb; asg_s[2 * t] = sa; asg_s[2 * t + 1] = sb; asg_w[2 * t] = w0; asg_w[2 * t + 1] = w1;
        tokl[ea * M + sa] = t; tokl[eb * M + sb] = t;
    }
    __syncthreads();
}

template <bool DUAL, class AL, class BL, class BL2, class EP>
DEVI void sgemm_tile(int m0, int n0, int K, AL aload, BL bload, BL2 bload2, EP epi, float* sm) {
    float* As = sm;
    float* Bs = sm + 16 * 132;
    float* Bs2 = Bs + 16 * 68;
    const int tid = opaque_tid(), ty = tid >> 4, tx = tid & 15;
    float acc[4][4], acc2[4][4];
#pragma unroll
    for (int i = 0; i < 4; ++i)
#pragma unroll
        for (int j = 0; j < 4; ++j) { acc[i][j] = 0.f; acc2[i][j] = 0.f; }
    for (int k0 = 0; k0 < K; k0 += 16) {
#pragma unroll
        for (int i = 0; i < 4; ++i) { const int e = tid + i * NT, r = e >> 4, kk = e & 15; As[kk * 132 + r] = aload(m0 + r, k0 + kk); }
#pragma unroll
        for (int i = 0; i < 2; ++i) { const int e = tid + i * NT, kk = e >> 6, n = e & 63; Bs[kk * 68 + n] = bload(k0 + kk, n0 + n); if (DUAL) Bs2[kk * 68 + n] = bload2(k0 + kk, n0 + n); }
        __syncthreads();
#pragma unroll
        for (int kk = 0; kk < 16; ++kk) {
            const float4 a = *(const float4*)(As + kk * 132 + ty * 4);
            const float4 b = *(const float4*)(Bs + kk * 68 + tx * 4);
            const float av[4] = {a.x, a.y, a.z, a.w}, bv[4] = {b.x, b.y, b.z, b.w};
#pragma unroll
            for (int i = 0; i < 4; ++i)
#pragma unroll
                for (int j = 0; j < 4; ++j) acc[i][j] = fmaf(av[i], bv[j], acc[i][j]);
            if (DUAL) {
                const float4 b2 = *(const float4*)(Bs2 + kk * 68 + tx * 4);
                const float bw[4] = {b2.x, b2.y, b2.z, b2.w};
#pragma unroll
                for (int i = 0; i < 4; ++i)
#pragma unroll
                    for (int j = 0; j < 4; ++j) acc2[i][j] = fmaf(av[i], bw[j], acc2[i][j]);
            }
        }
        __syncthreads();
    }
#pragma unroll
    for (int i = 0; i < 4; ++i)
#pragma unroll
        for (int j = 0; j < 4; ++j) epi(m0 + ty * 4 + i, n0 + tx * 4 + j, acc[i][j], acc2[i][j]);
}

DEVI void s1_inproj(const P& p, float* sm) {
    const float* x = p.in[I_X]; const float* w = p.in[I_WIN]; bf16_t* hb = (bf16_t*)(p.ws + WS_HB);
#if NAIVE_INPROJ
    const int ntn = INW / 64, nt = (M / 128) * ntn;
    for (int it = blockIdx.x; it < nt; it += gridDim.x) {
        const int m0 = (it / ntn) * 128, n0 = (it % ntn) * 64;
        auto al = [&](int r, int k) { return x[(size_t)r * D + k]; };
        auto bl = [&](int k, int n) { return w[(size_t)k * INW + n]; };
        auto ep = [&](int r, int n, float v, float) { hb[(size_t)r * INW + n] = f2bf(v); };
        sgemm_tile<false>(m0, n0, D, al, bl, bl, ep, sm);
    }
#else
    (void)x; (void)w; (void)hb;
#endif
    const float* mem = p.in[I_MEM]; const float* wkv = p.in[I_WKV]; bf16_t* kb = (bf16_t*)(p.ws + WS_KB); bf16_t* vt = (bf16_t*)(p.ws + WS_VT);
    const int nt2 = NAIVE_KV ? (BATCH * MEMLEN / 128) * (2 * MEMW / 64) : 0;
    for (int it = blockIdx.x; it < nt2; it += gridDim.x) {
        const int m0 = (it / 16) * 128, n0 = (it % 16) * 64;
        auto al = [&](int r, int k) { return mem[(size_t)r * D + k]; };
        auto bl = [&](int k, int n) { return wkv[(size_t)k * (2 * MEMW) + n]; };
        auto ep = [&](int r, int n, float v, float) {
            const int b = r / MEMLEN, key = r % MEMLEN;
            if (n < MEMW) { const int hd = n >> 7, d = n & 127; kb[((size_t)(b * 4 + hd) * MEMLEN + key) * 128 + d] = f2bf(v); }
            else { const int n2 = n - MEMW, hd = n2 >> 7, d = n2 & 127; vt[((size_t)(b * 4 + hd) * 128 + d) * MEMLEN + permkey(key)] = f2bf(v); }
        };
        sgemm_tile<false>(m0, n0, D, al, bl, bl, ep, sm);
    }
}
DEVI void s2a_pool(const P& p, float* sm) {
    const bf16_t* hb = (const bf16_t*)(p.ws + WS_HB); float* ypool = (float*)(p.ws + WS_YPOOL);
    const float* wp = p.in[I_WPOOL]; const float* ps = p.in[I_PSCALE];
    const int tid = opaque_tid(), g = tid >> 7, c = tid & 127, w = 2 << g;
    for (int t = blockIdx.x; t < M; t += gridDim.x) {
        const int pos = t % SEQ;
        float s = 0.f;
        for (int j = 0; j < w; ++j) if (pos - j >= 0) s += bf2f(hb[(size_t)(t - j) * INW + g * 128 + c]);
        const float cntf = (float)((pos + 1 < w) ? pos + 1 : w);
        sm[tid] = s / cntf - bf2f(hb[(size_t)t * INW + g * 128 + c]);
        __syncthreads();
        float y = 0.f;
        for (int cc = 0; cc < 128; ++cc) y = fmaf(sm[g * 128 + cc], wp[((size_t)g * 128 + cc) * 128 + c], y);
        ypool[(size_t)t * POOLW + g * 128 + c] = y * ps[g * 128 + c];
        __syncthreads();
    }
}
DEVI float sigmoidf_(float v) { return 1.f / (1.f + __expf(-v)); }
DEVI void s2b_lru(const P& p, float* sm) {
    const bf16_t* hb = (const bf16_t*)(p.ws + WS_HB); float* aS = (float*)(p.ws + WS_AS); float* bS = (float*)(p.ws + WS_BS);
    const float* cw = p.in[I_CONVW]; const float* cb = p.in[I_CONVB]; const float* wa = p.in[I_WA]; const float* ba = p.in[I_BA];
    const float* wx = p.in[I_WX]; const float* bx = p.in[I_BX]; const float* lam = p.in[I_LAM];
    const int tid = opaque_tid();
    for (int it = blockIdx.x; it < M / 8; it += gridDim.x) {
        const int t0 = it * 8;
#pragma unroll
        for (int q = 0; q < 2; ++q) { const int c = tid + q * NT;
            for (int tt = 0; tt < 8; ++tt) { const int t = t0 + tt, pos = t % SEQ; float u = cb[c];
#pragma unroll
                for (int j = 0; j < 4; ++j) if (pos - 3 + j >= 0) u = fmaf(cw[j * LRUW + c], bf2f(hb[(size_t)(t - 3 + j) * INW + POOLW + c]), u);
                sm[tt * LRUW + c] = u; } }
        __syncthreads();
#pragma unroll
        for (int q = 0; q < 2; ++q) { const int n = tid + q * NT, h = n >> 7, nn = n & 127;
            float ra[8], rx[8];
#pragma unroll
            for (int tt = 0; tt < 8; ++tt) { ra[tt] = ba[n]; rx[tt] = bx[n]; }
            for (int c = 0; c < 128; ++c) { const float w1 = wa[((size_t)h * 128 + c) * 128 + nn], w2 = wx[((size_t)h * 128 + c) * 128 + nn];
#pragma unroll
                for (int tt = 0; tt < 8; ++tt) { const float u = sm[tt * LRUW + h * 128 + c]; ra[tt] = fmaf(u, w1, ra[tt]); rx[tt] = fmaf(u, w2, rx[tt]); } }
            const float sp = log1pf(expf(-lam[n]));
#pragma unroll
            for (int tt = 0; tt < 8; ++tt) { const float r = sigmoidf_(ra[tt]), ii = sigmoidf_(rx[tt]);
                const float la = -8.f * r * sp, a = expf(la), mult = sqrtf(fmaxf(-expm1f(2.f * la), 0.f));
                aS[(size_t)(t0 + tt) * LRUW + n] = a; bS[(size_t)(t0 + tt) * LRUW + n] = mult * ii * sm[tt * LRUW + n]; } }
        __syncthreads();
    }
}
DEVI float gelu_tanh(float v) { const float u = 0.7978845608028654f * (v + 0.044715f * v * v * v); return 0.5f * v * (1.f + tanhf(u)); }
DEVI void s2c_scan(const P& p, float*) {
    const bf16_t* hb = (const bf16_t*)(p.ws + WS_HB); const float* aS = (const float*)(p.ws + WS_AS); const float* bS = (const float*)(p.ws + WS_BS); float* ylru = (float*)(p.ws + WS_YLRU);
    const int idx = blockIdx.x * NT + threadIdx.x;
    if (idx >= BATCH * LRUW) return;
    const int b = idx / LRUW, c = idx % LRUW; float h = 0.f;
    for (int s0 = 0; s0 < SEQ; s0 += 8) {
        float a[8], bb[8], g[8];
#pragma unroll
        for (int j = 0; j < 8; ++j) { const size_t t = (size_t)b * SEQ + s0 + j; a[j] = aS[t * LRUW + c]; bb[j] = bS[t * LRUW + c]; g[j] = bf2f(hb[t * INW + POOLW + LRUW + c]); }
#pragma unroll
        for (int j = 0; j < 8; ++j) { h = fmaf(a[j], h, bb[j]); ylru[((size_t)b * SEQ + s0 + j) * LRUW + c] = gelu_tanh(g[j]) * h; }
    }
}
DEVI void s2d_attn(const P& p, float* sm) {
    const bf16_t* hb = (const bf16_t*)(p.ws + WS_HB); const bf16_t* kb = (const bf16_t*)(p.ws + WS_KB); const bf16_t* vt = (const bf16_t*)(p.ws + WS_VT); float* ymem = (float*)(p.ws + WS_YMEM);
    const int tid = opaque_tid(), wv = tid >> 6, lane = tid & 63;
    float* qs = sm + wv * 384; float* ps = qs + 128;
    for (int it = blockIdx.x; it < M / 2; it += gridDim.x) {
        const int t = it * 2 + (wv >> 2), hd = wv & 3, b = t / SEQ;
        qs[lane] = bf2f(hb[(size_t)t * INW + POOLW + 2 * LRUW + hd * 128 + lane]); qs[lane + 64] = bf2f(hb[(size_t)t * INW + POOLW + 2 * LRUW + hd * 128 + lane + 64]);
        __syncthreads();
        float sc[4];
#pragma unroll
        for (int j = 0; j < 4; ++j) { const int key = lane + 64 * j; const bf16_t* kr = kb + ((size_t)(b * 4 + hd) * MEMLEN + key) * 128; float s = 0.f;
            for (int d = 0; d < 128; ++d) s = fmaf(qs[d], bf2f(kr[d]), s);
            sc[j] = s * 0.08838834764831845f; }
        const float mx = wave_max(fmaxf(fmaxf(sc[0], sc[1]), fmaxf(sc[2], sc[3])));
        float e[4], es = 0.f;
#pragma unroll
        for (int j = 0; j < 4; ++j) { e[j] = __expf(sc[j] - mx); es += e[j]; }
        const float inv = 1.f / wave_sum(es);
#pragma unroll
        for (int j = 0; j < 4; ++j) ps[lane + 64 * j] = e[j] * inv;
        __syncthreads();
#pragma unroll
        for (int q = 0; q < 2; ++q) { const int d = lane + 64 * q; const bf16_t* vr = vt + ((size_t)(b * 4 + hd) * 128 + d) * MEMLEN; float o = 0.f;
            for (int key = 0; key < MEMLEN; ++key) o = fmaf(ps[key], bf2f(vr[permkey(key)]), o);
            ymem[(size_t)t * MEMW + hd * 128 + d] = o; }
        __syncthreads();
    }
}
template <bool DO_POOL, bool DO_LRU, bool DO_MEM> DEVI void s2e_norm(const P& p, float* sm) {
    const float* ypool = (const float*)(p.ws + WS_YPOOL); const float* ylru = (const float*)(p.ws + WS_YLRU); const float* ymem = (const float*)(p.ws + WS_YMEM);
    const float* g = p.in[I_MIXG]; bf16_t* mix = (bf16_t*)(p.ws + WS_MIX);
    const int tid = opaque_tid(), wv = tid >> 6, lane = tid & 63;
    for (int t = blockIdx.x; t < M; t += gridDim.x) {
        const float a = ypool[(size_t)t * POOLW + tid], b0 = ylru[(size_t)t * LRUW + tid], b1 = ylru[(size_t)t * LRUW + tid + NT], c = ymem[(size_t)t * MEMW + tid];
        const float s0 = wave_sum(a * a), s1 = wave_sum(b0 * b0 + b1 * b1), s2 = wave_sum(c * c);
        if (lane == 0) { sm[wv] = s0; sm[8 + wv] = s1; sm[16 + wv] = s2; }
        __syncthreads();
        float t0 = 0.f, t1 = 0.f, t2 = 0.f;
#pragma unroll
        for (int i = 0; i < 8; ++i) { t0 += sm[i]; t1 += sm[8 + i]; t2 += sm[16 + i]; }
        const float r0 = rsqrtf(t0 / POOLW + EPS), r1 = rsqrtf(t1 / LRUW + EPS), r2 = rsqrtf(t2 / MEMW + EPS);
        bf16_t* mr = mix + (size_t)t * MIXW;
        if (DO_POOL) mr[tid] = f2bf(a * r0 * g[tid]);
        if (DO_LRU) { mr[POOLW + tid] = f2bf(b0 * r1 * g[POOLW + tid]); mr[POOLW + NT + tid] = f2bf(b1 * r1 * g[POOLW + NT + tid]); }
        if (DO_MEM) mr[POOLW + LRUW + tid] = f2bf(c * r2 * g[POOLW + LRUW + tid]);
        __syncthreads();
    }
}
DEVI void s3_outproj(const P& p, float* sm) {
    const float* x = p.in[I_X]; const float* w = p.in[I_WOUT]; const bf16_t* mix = (const bf16_t*)(p.ws + WS_MIX); float* z = p.out;
    const int ntn = D / 64, nt = (M / 128) * ntn;
    for (int it = blockIdx.x; it < nt; it += gridDim.x) {
        const int m0 = (it / ntn) * 128, n0 = (it % ntn) * 64;
        auto al = [&](int r, int k) { return bf2f(mix[(size_t)r * MIXW + k]); };
        auto bl = [&](int k, int n) { return w[(size_t)k * D + n]; };
        auto ep = [&](int r, int n, float v, float) { z[(size_t)r * D + n] = fmaf(ALPHA, x[(size_t)r * D + n], v); };
        sgemm_tile<false>(m0, n0, MIXW, al, bl, bl, ep, sm);
    }
}
DEVI void s4a_route(const P& p, float*) {
    const float* z = p.out; bf16_t* x1b = (bf16_t*)(p.ws + WS_X1B);
    const float* g1 = p.in[I_LN1G]; const float* b1 = p.in[I_LN1B]; const float* wg = p.in[I_WGROUP]; const float* bg = p.in[I_BGROUP]; const float* wf = p.in[I_WFINE]; const float* bfine = p.in[I_BFINE];
    int* cnt = (int*)(p.ws + WS_CTL) + CW_CNT; int* asg_e = (int*)(p.ws + WS_ASG_E); int* asg_s = (int*)(p.ws + WS_ASG_S); float* asg_w = (float*)(p.ws + WS_ASG_W);
    const int tid = opaque_tid(), wv = tid >> 6, lane = tid & 63;
    for (int t = blockIdx.x * 8 + wv; t < M; t += gridDim.x * 8) {
        float v[32]; float s = 0.f;
#pragma unroll
        for (int j = 0; j < 8; ++j) { const float4 q = *(const float4*)(z + (size_t)t * D + j * 256 + lane * 4); v[4 * j] = q.x; v[4 * j + 1] = q.y; v[4 * j + 2] = q.z; v[4 * j + 3] = q.w; s += (q.x + q.y) + (q.z + q.w); }
        const float mean = wave_sum(s) * (1.f / D); float s2 = 0.f;
#pragma unroll
        for (int i = 0; i < 32; ++i) { v[i] -= mean; s2 = fmaf(v[i], v[i], s2); }
        const float rstd = rsqrtf(wave_sum(s2) * (1.f / D) + EPS);
#pragma unroll
        for (int j = 0; j < 8; ++j) {
#pragma unroll
            for (int i = 0; i < 4; ++i) { const int k = j * 256 + lane * 4 + i; v[4 * j + i] = v[4 * j + i] * rstd * g1[k] + b1[k]; }
            ushort4 o; o.x = f2bf(v[4 * j]); o.y = f2bf(v[4 * j + 1]); o.z = f2bf(v[4 * j + 2]); o.w = f2bf(v[4 * j + 3]);
            *(ushort4*)(x1b + (size_t)t * D + j * 256 + lane * 4) = o; }
        float lg[4], lf[32];
#pragma unroll
        for (int o = 0; o < 4; ++o) lg[o] = 0.f;
#pragma unroll
        for (int o = 0; o < 32; ++o) lf[o] = 0.f;
#pragma unroll
        for (int j = 0; j < 8; ++j) {
#pragma unroll
            for (int i = 0; i < 4; ++i) { const int k = j * 256 + lane * 4 + i; const float xv = v[4 * j + i];
                const float4 g4 = *(const float4*)(wg + (size_t)k * NG);
                lg[0] = fmaf(xv, g4.x, lg[0]); lg[1] = fmaf(xv, g4.y, lg[1]); lg[2] = fmaf(xv, g4.z, lg[2]); lg[3] = fmaf(xv, g4.w, lg[3]);
#pragma unroll
                for (int q = 0; q < 8; ++q) { const float4 f4 = *(const float4*)(wf + (size_t)k * NE + 4 * q);
                    lf[4 * q] = fmaf(xv, f4.x, lf[4 * q]); lf[4 * q + 1] = fmaf(xv, f4.y, lf[4 * q + 1]); lf[4 * q + 2] = fmaf(xv, f4.z, lf[4 * q + 2]); lf[4 * q + 3] = fmaf(xv, f4.w, lf[4 * q + 3]); } }
            asm volatile("" ::: "memory");
        }
#pragma unroll
        for (int o = 0; o < 4; ++o) lg[o] = wave_sum(lg[o]) + bg[o];
#pragma unroll
        for (int o = 0; o < 32; ++o) lf[o] = wave_sum(lf[o]);
        int gi = 0; float gm = lg[0];
#pragma unroll
        for (int o = 1; o < 4; ++o) if (lg[o] > gm) { gm = lg[o]; gi = o; }
        float ge = 0.f;
#pragma unroll
        for (int o = 0; o < 4; ++o) ge += __expf(lg[o] - gm);
        const float gp = 1.f / ge;
        float fs[8];
#pragma unroll
        for (int j = 0; j < 8; ++j) { float q = lf[j];
#pragma unroll
            for (int o = 1; o < 4; ++o) q = (gi == o) ? lf[o * 8 + j] : q;
            fs[j] = q + bfine[gi * 8 + j]; }
        int i0 = 0; float l0 = fs[0];
#pragma unroll
        for (int j = 1; j < 8; ++j) if (fs[j] > l0) { l0 = fs[j]; i0 = j; }
        int i1 = -1; float l1 = -3.0e38f;
#pragma unroll
        for (int j = 0; j < 8; ++j) if (j != i0 && fs[j] > l1) { l1 = fs[j]; i1 = j; }
        const float e1 = __expf(l1 - l0), w0 = gp / (1.f + e1), w1 = gp * e1 / (1.f + e1);
        if (lane == 0) {
            const int ea = gi * 8 + i0, eb = gi * 8 + i1;
            const int sa = atomicAdd(&cnt[ea], 1), sb = atomicAdd(&cnt[eb], 1);
            asg_e[2 * t] = ea; asg_e[2 * t + 1] = eb; asg_s[2 * t] = sa; asg_s[2 * t + 1] = sb; asg_w[2 * t] = w0; asg_w[2 * t + 1] = w1;
        }
    }
}
DEVI void load_offs(const P& p, int* offs) {
    const int* cnt = (const int*)(p.ws + WS_CTL) + CW_CNT;
    if (threadIdx.x == 0) { int o = 0; for (int e = 0; e < NE; ++e) { offs[e] = o; o += (cnt[e] + 255) / 256 * 256; } offs[NE] = o; }
    __syncthreads();
}
DEVI void s4b_gather(const P& p, float* sm) {
    int* offs = (int*)sm; load_offs(p, offs);
    const bf16_t* x1b = (const bf16_t*)(p.ws + WS_X1B); bf16_t* xg = (bf16_t*)(p.ws + WS_XG);
    const int* asg_e = (const int*)(p.ws + WS_ASG_E); const int* asg_s = (const int*)(p.ws + WS_ASG_S); int* asg_r = (int*)(p.ws + WS_ASG_R);
    const int tid = opaque_tid(), wv = tid >> 6, lane = tid & 63;
    for (int t = blockIdx.x * 8 + wv; t < M; t += gridDim.x * 8) {
        const uint4 a = *(const uint4*)(x1b + (size_t)t * D + lane * 8), b = *(const uint4*)(x1b + (size_t)t * D + 512 + lane * 8),
                    c = *(const uint4*)(x1b + (size_t)t * D + 1024 + lane * 8), d = *(const uint4*)(x1b + (size_t)t * D + 1536 + lane * 8);
#pragma unroll
        for (int k = 0; k < 2; ++k) { const int row = offs[asg_e[2 * t + k]] + asg_s[2 * t + k]; bf16_t* dst = xg + (size_t)row * D;
            *(uint4*)(dst + lane * 8) = a; *(uint4*)(dst + 512 + lane * 8) = b; *(uint4*)(dst + 1024 + lane * 8) = c; *(uint4*)(dst + 1536 + lane * 8) = d;
            if (lane == 0) asg_r[2 * t + k] = row; }
    }
}
DEVI int expert_of_row(const int* offs, int row) { int e = 0; for (int i = 1; i < NE; ++i) if (row >= offs[i]) e = i; return e; }
DEVI float silu_(float v) { return v / (1.f + __expf(-v)); }
DEVI void s5_expert1(const P& p, float* sm) {
    int* offs = (int*)(sm + 8192); load_offs(p, offs);
    const bf16_t* xg = (const bf16_t*)(p.ws + WS_XG); bf16_t* hd = (bf16_t*)(p.ws + WS_HD);
    const int ntn = FF / 64, nt = (offs[NE] / 128) * ntn;
    for (int it = blockIdx.x; it < nt; it += gridDim.x) {
        const int m0 = (it / ntn) * 128, n0 = (it % ntn) * 64, e = expert_of_row(offs, m0);
        const float* wgt = p.in[I_WGATE] + (size_t)e * D * FF; const float* wup = p.in[I_WUP] + (size_t)e * D * FF;
        auto al = [&](int r, int k) { return bf2f(xg[(size_t)r * D + k]); };
        auto bl = [&](int k, int n) { return wgt[(size_t)k * FF + n]; };
        auto bl2 = [&](int k, int n) { return wup[(size_t)k * FF + n]; };
        auto ep = [&](int r, int n, float g, float u) { hd[(size_t)r * FF + n] = f2bf(silu_(g) * u); };
        sgemm_tile<true>(m0, n0, D, al, bl, bl2, ep, sm);
    }
}
DEVI void s6_expert2(const P& p, float* sm) {
    int* offs = (int*)(sm + 8192); load_offs(p, offs);
    const bf16_t* hd = (const bf16_t*)(p.ws + WS_HD); bf16_t* yb = (bf16_t*)(p.ws + WS_YB);
    const int ntn = D / 64, nt = (offs[NE] / 128) * ntn;
    for (int it = blockIdx.x; it < nt; it += gridDim.x) {
        const int m0 = (it / ntn) * 128, n0 = (it % ntn) * 64, e = expert_of_row(offs, m0);
        const float* wd = p.in[I_WDOWN] + (size_t)e * FF * D;
        auto al = [&](int r, int k) { return bf2f(hd[(size_t)r * FF + k]); };
        auto bl = [&](int k, int n) { return wd[(size_t)k * D + n]; };
        auto ep = [&](int r, int n, float v, float) { yb[(size_t)r * D + n] = f2bf(v); };
        sgemm_tile<false>(m0, n0, FF, al, bl, bl, ep, sm);
    }
}
DEVI void s7_final(const P& p, float* sm) {
    int* offs = (int*)sm; load_offs(p, offs);
    const bf16_t* x1b = (const bf16_t*)(p.ws + WS_X1B); const bf16_t* yb = (const bf16_t*)(p.ws + WS_YB);
    const int* asg_e = (const int*)(p.ws + WS_ASG_E); const int* asg_s = (const int*)(p.ws + WS_ASG_S); const float* asg_w = (const float*)(p.ws + WS_ASG_W);
    const float* g2 = p.in[I_LN2G]; const float* b2 = p.in[I_LN2B]; float* out = p.out;
    const int tid = opaque_tid(), wv = tid >> 6, lane = tid & 63;
    for (int t = blockIdx.x * 8 + wv; t < M; t += gridDim.x * 8) {
        const int r0 = offs[asg_e[2 * t]] + asg_s[2 * t], r1 = offs[asg_e[2 * t + 1]] + asg_s[2 * t + 1]; const float w0 = asg_w[2 * t], w1 = asg_w[2 * t + 1];
        float v[32]; float s = 0.f;
#pragma unroll
        for (int j = 0; j < 8; ++j) { const int k = j * 256 + lane * 4;
            const ushort4 a = *(const ushort4*)(x1b + (size_t)t * D + k), y0 = *(const ushort4*)(yb + (size_t)r0 * D + k), y1 = *(const ushort4*)(yb + (size_t)r1 * D + k);
            v[4 * j] = ALPHA * bf2f(a.x) + w0 * bf2f(y0.x) + w1 * bf2f(y1.x); v[4 * j + 1] = ALPHA * bf2f(a.y) + w0 * bf2f(y0.y) + w1 * bf2f(y1.y);
            v[4 * j + 2] = ALPHA * bf2f(a.z) + w0 * bf2f(y0.z) + w1 * bf2f(y1.z); v[4 * j + 3] = ALPHA * bf2f(a.w) + w0 * bf2f(y0.w) + w1 * bf2f(y1.w);
            s += (v[4 * j] + v[4 * j + 1]) + (v[4 * j + 2] + v[4 * j + 3]); }
        const float mean = wave_sum(s) * (1.f / D); float s2 = 0.f;
#pragma unroll
        for (int i = 0; i < 32; ++i) { v[i] -= mean; s2 = fmaf(v[i], v[i], s2); }
        const float rstd = rsqrtf(wave_sum(s2) * (1.f / D) + EPS);
#pragma unroll
        for (int j = 0; j < 8; ++j) { const int k = j * 256 + lane * 4; const float4 g = *(const float4*)(g2 + k), b = *(const float4*)(b2 + k);
            float4 o; o.x = v[4 * j] * rstd * g.x + b.x; o.y = v[4 * j + 1] * rstd * g.y + b.y; o.z = v[4 * j + 2] * rstd * g.z + b.z; o.w = v[4 * j + 3] * rstd * g.w + b.w;
            *(float4*)(out + (size_t)t * D + k) = o; }
    }
}

constexpr int NSTAGE = 12;
template <int S> DEVI void run_stage(const P& p, float* sm) {
    if (S == 0) s1_inproj(p, sm);
    if (S == 1) s2a_pool(p, sm);
    if (S == 2) s2b_lru(p, sm);
    if (S == 3) s2c_scan(p, sm);
    if (S == 4) s2d_attn(p, sm);
    if (S == 5) s2e_norm<true, true, false>(p, sm);
    if (S == 6) s3_outproj(p, sm);
    if (S == 7) s4a_route(p, sm);
    if (S == 8) s4b_gather(p, sm);
    if (S == 9) s5_expert1(p, sm);
    if (S == 10) s6_expert2(p, sm);
    if (S == 11) s7_final(p, sm);
}

constexpr int LDS_BYTES = 144 * 1024;
__global__ void __launch_bounds__(NT, 2) mega_fwd(P p) {
    extern __shared__ __attribute__((aligned(16))) unsigned char lds[];
    float* sm = (float*)lds;
    volatile LAS unsigned* bst = (volatile LAS unsigned*)((LAS unsigned char*)lds + LDS_BYTES - 64);
    if (threadIdx.x < 2) bst[threadIdx.x] = 0u;
    __syncthreads();
    const XcdBarrier bar = xcd_barrier_post((unsigned*)(p.ws + WS_CTL) + CW_BAR, bst);
    p0_prologue(p, lds); __syncthreads(); p0_kv(p, lds); run_stage<0>(p, sm); xcd_barrier(bar);
    if (blockIdx.x & 1) { convert_experts(p, lds, blockIdx.x, gridDim.x); __syncthreads(); }
    p1_inproj(p, lds);
    if (!(blockIdx.x & 1)) { __syncthreads(); convert_experts(p, lds, blockIdx.x, gridDim.x); }
    xcd_barrier(bar);
    for (int tile = blockIdx.x; tile < M / 64; tile += gridDim.x) { p2_lru_local(p, tile); p2_pool(p, lds, tile); p2_attn(p, lds, tile); }
    xcd_barrier(bar);
    for (int tile = blockIdx.x; tile < M / 64; tile += gridDim.x) p2_lru_final(p, lds, tile);
    xcd_barrier(bar);
    p3_outproj(p, lds); xcd_barrier(bar);
    for (int tile = blockIdx.x; tile < M / 64; tile += gridDim.x) p4_route(p, lds, tile);
    xcd_barrier(bar);
    p5_expert1(p, lds); xcd_barrier(bar);
    p6_expert2(p, lds); xcd_barrier(bar);
    run_stage<11>(p, sm);
}
template <int S> __global__ void __launch_bounds__(NT, 2) stage_kernel(P p) {
    extern __shared__ __attribute__((aligned(16))) unsigned char lds[];
    run_stage<S>(p, (float*)lds);
}

extern "C" void kernel_launch(void* const* d_in, const int* in_sizes, int n_in, void* d_out, int out_size, void* d_ws, size_t ws_size, hipStream_t stream) {
    static int grid = 0;
    if (grid == 0) {
        if (n_in != 26 || out_size != M * D || ws_size < WS_END) { fprintf(stderr, "kernel_launch: unexpected shapes: n_in %d out %d ws %zu (need %zu)\n", n_in, out_size, ws_size, (size_t)WS_END); grid = -1; return; }
        int dev = 0, cus = 0, per_cu = 0;
        (void)hipGetDevice(&dev); (void)hipDeviceGetAttribute(&cus, hipDeviceAttributeMultiprocessorCount, dev);
        (void)hipFuncSetAttribute((const void*)mega_fwd, hipFuncAttributeMaxDynamicSharedMemorySize, LDS_BYTES);
        (void)hipOccupancyMaxActiveBlocksPerMultiprocessor(&per_cu, (const void*)mega_fwd, NT, LDS_BYTES);
        if (per_cu < 1) { fprintf(stderr, "kernel_launch: occupancy query says %d blocks per CU\n", per_cu); per_cu = 1; }
        grid = cus;
        fprintf(stderr, "kernel_launch: cus %d per_cu %d grid %d ws %zu\n", cus, per_cu, grid, ws_size);
    }
    if (grid < 0) return;
    (void)hipMemsetAsync((char*)d_ws + WS_CTL, 0, 1 * MiB, stream);
    P p{};
    for (int i = 0; i < 26; ++i) p.in[i] = (const float*)d_in[i];
    p.out = (float*)d_out; p.ws = (unsigned char*)d_ws;
#if ONE_LAUNCH
    void* args[] = {&p};
    hipError_t e = hipLaunchCooperativeKernel((const void*)mega_fwd, dim3(grid), dim3(NT), args, LDS_BYTES, stream);
    if (e != hipSuccess) fprintf(stderr, "cooperative launch failed: %s (grid %d)\n", hipGetErrorString(e), grid);
#else
    const int g2 = grid * 1;
#define LAUNCH(S) do { hipFuncSetAttribute((const void*)stage_kernel<S>, hipFuncAttributeMaxDynamicSharedMemorySize, LDS_BYTES); hipLaunchKernelGGL(stage_kernel<S>, dim3(g2), dim3(NT), LDS_BYTES, stream, p); } while (0)
    LAUNCH(0); LAUNCH(1); LAUNCH(2); LAUNCH(4); LAUNCH(3); LAUNCH(5); LAUNCH(6); LAUNCH(7); LAUNCH(8); LAUNCH(9); LAUNCH(10); LAUNCH(11);
#endif
}
```
